# Optimizing an MI355X kernel written in HIP

```python
import jax
import jax.numpy as jnp
from jax import lax
import numpy as np

D_MODEL = 1024
BATCH = 2
SEQ = 8192
DEPTH = 2

GRID_W = 64
CTX_LEN = 256
MLA_HEADS = 8
QK_NOPE = 128
QK_ROPE = 64
QK_DIM = QK_NOPE + QK_ROPE
V_HEAD = 128
Q_LORA = 256
KV_LORA = 128
ROPE_THETA = 10000.0
ATTN_SCALE = QK_DIM ** -0.5
Q_BLOCK = 128
LRU_WIDTH = D_MODEL
LRU_BLOCKS = 16
LRU_BW = LRU_WIDTH // LRU_BLOCKS
CONV_W = 4
LRU_C = 8.0
N_EXPERTS = 32
TOP_K = 4
D_FF = D_MODEL
SWIGLU_ALPHA = 1.702
SWIGLU_LIMIT = 7.0
MOE_BLOCK = 128
NORM_EPS = 1e-6
IN_SPLITS = (Q_LORA, KV_LORA, QK_ROPE, LRU_WIDTH, LRU_WIDTH, D_MODEL, D_MODEL)
D_IN = Q_LORA + KV_LORA + QK_ROPE + 2 * LRU_WIDTH + 2 * D_MODEL

kernel_name = 'hybrid_mla_rglru_moe_dit'


def rmsnorm(x, g):
    xf = x.astype(jnp.float32)
    y = xf * lax.rsqrt(jnp.mean(xf * xf, axis=-1, keepdims=True) + NORM_EPS)
    return (y * g.astype(jnp.float32)).astype(x.dtype)


def modulate(x, shift, scale):
    return x * (1 + scale) + shift


def adaln(cond, w, b):
    m = jax.nn.silu(cond) @ w + b
    return jnp.split(m[:, None, :], 6, axis=-1)


def split_cols(z):
    offs = []
    acc = 0
    for wdt in IN_SPLITS[:-1]:
        acc += wdt
        offs.append(acc)
    return jnp.split(z, offs, axis=-1)


def axial_rope_tables(n_tokens):
    rows = n_tokens // GRID_W
    row = jnp.repeat(jnp.arange(rows, dtype=jnp.float32), GRID_W)
    col = jnp.tile(jnp.arange(GRID_W, dtype=jnp.float32), rows)
    n_freq = QK_ROPE // 4
    inv = ROPE_THETA ** (-jnp.arange(n_freq, dtype=jnp.float32) / n_freq)
    ang = jnp.concatenate([row[:, None] * inv, col[:, None] * inv], axis=-1)
    return jnp.cos(ang), jnp.sin(ang)


def apply_axial_rope(x, cos, sin):
    xr = x.reshape(x.shape[:-1] + (2, 2, QK_ROPE // 4))
    x1, x2 = xr[..., 0, :], xr[..., 1, :]
    c = cos.reshape(cos.shape[:-1] + (2, QK_ROPE // 4))
    s = sin.reshape(sin.shape[:-1] + (2, QK_ROPE // 4))
    out = jnp.stack([x1 * c - x2 * s, x1 * s + x2 * c], axis=-2)
    return out.reshape(x.shape)


def mla_queries(c_q, p, cos, sin):
    b, n, _ = c_q.shape
    q = (rmsnorm(c_q, p['q_norm']) @ p['w_uq']).reshape(b, n, MLA_HEADS, QK_DIM)
    if cos is None:
        return q
    q_pe = apply_axial_rope(q[..., QK_NOPE:], cos[:, None, :], sin[:, None, :])
    return jnp.concatenate([q[..., :QK_NOPE], q_pe], axis=-1)


def mla_keys_values(c_kv, k_pe, p, cos, sin):
    b, n, _ = c_kv.shape
    kv = (rmsnorm(c_kv, p['kv_norm']) @ p['w_ukv']).reshape(b, n, MLA_HEADS, QK_NOPE + V_HEAD)
    k_nope, v = kv[..., :QK_NOPE], kv[..., QK_NOPE:]
    if cos is not None:
        k_pe = apply_axial_rope(k_pe, cos, sin)
    k_pe = jnp.broadcast_to(k_pe[:, :, None, :], (b, n, MLA_HEADS, QK_ROPE))
    return jnp.concatenate([k_nope, k_pe], axis=-1), v


def softmax_attend(q, k, v):
    s = jnp.einsum('bqhd,bkhd->bhqk', q, k).astype(jnp.float32) * ATTN_SCALE
    pr = jax.nn.softmax(s, axis=-1).astype(v.dtype)
    return jnp.einsum('bhqk,bkhd->bqhd', pr, v)


def dwconv(x, w, b):
    n = x.shape[1]
    lo = CONV_W // 2
    xp = jnp.pad(x, ((0, 0), (lo, CONV_W - 1 - lo), (0, 0)))
    y = b
    for k in range(CONV_W):
        y = y + xp[:, k:k + n] * w[k]
    return y


def linear_scan(a, u, h0, reverse):
    edge = -1 if reverse else 0
    u = u.at[:, edge].add(a[:, edge] * h0)

    def combine(left, right):
        a_l, u_l = left
        a_r, u_r = right
        return a_l * a_r, a_r * u_l + u_r

    _, h = lax.associative_scan(combine, (a, u), reverse=reverse, axis=1)
    return h


def rglru_direction(x, w_a, b_a, w_x, b_x, lam, h0, reverse):
    b, n, wdt = x.shape
    xb = x.reshape(b, n, LRU_BLOCKS, LRU_BW)
    r = jax.nn.sigmoid(jnp.einsum('bsnj,njk->bsnk', xb, w_a).reshape(b, n, wdt) + b_a)
    i = jax.nn.sigmoid(jnp.einsum('bsnj,njk->bsnk', xb, w_x).reshape(b, n, wdt) + b_x)
    log_a = -LRU_C * jax.nn.softplus(-lam.astype(jnp.float32)) * r.astype(jnp.float32)
    a = jnp.exp(log_a)
    u = jnp.sqrt(-jnp.expm1(2.0 * log_a)) * (i * x).astype(jnp.float32)
    return linear_scan(a, u, h0, reverse)


def lru_dir(p, d):
    return (p['lru_w_a'][d], p['lru_b_a'][d], p['lru_w_x'][d], p['lru_b_x'][d], p['lru_lambda'][d])


def merge_branches(att, lru, g_att, g_lru, p):
    y_att = att @ p['w_o_attn']
    y_lru = lru @ p['w_o_lru']
    m = (jax.nn.sigmoid(g_att + p['b_branch_gate'][:D_MODEL]) * y_att
         + jax.nn.sigmoid(g_lru + p['b_branch_gate'][D_MODEL:]) * y_lru)
    return m @ p['w_out']


def token_mixer(h, hc, p, cos, sin, need_ctx):
    b, n, _ = h.shape
    c_q, c_kv, k_pe, x_r, g_r, g_att, g_lru = split_cols(h @ p['w_in'])
    cc_q, cc_kv, ck_pe, cx_r, cg_r, cg_att, cg_lru = split_cols(hc @ p['w_in'])
    q = mla_queries(c_q, p, cos, sin)
    k, v = mla_keys_values(c_kv, k_pe, p, cos, sin)
    ck, cv = mla_keys_values(cc_kv, ck_pe, p, None, None)
    k_all = jnp.concatenate([ck, k], axis=1)
    v_all = jnp.concatenate([cv, v], axis=1)
    n_blk = n // Q_BLOCK
    qb = q.reshape(b, n_blk, Q_BLOCK, MLA_HEADS, QK_DIM).transpose(1, 0, 2, 3, 4)
    ob = lax.map(lambda qq: softmax_attend(qq, k_all, v_all), qb)
    att = ob.transpose(1, 0, 2, 3, 4).reshape(b, n, MLA_HEADS * V_HEAD)
    xl = dwconv(x_r, p['conv_w'], p['conv_b'])
    xc = dwconv(cx_r, p['conv_w'], p['conv_b'])
    zeros = jnp.zeros((b, LRU_WIDTH), jnp.float32)
    hc_f = rglru_direction(xc, *lru_dir(p, 0), zeros, False)
    hc_b = rglru_direction(xc, *lru_dir(p, 1), zeros, True)
    h_f = rglru_direction(xl, *lru_dir(p, 0), hc_f[:, -1], False)
    h_b = rglru_direction(xl, *lru_dir(p, 1), hc_b[:, 0], True)
    lru = (h_f + h_b).astype(h.dtype) * jax.nn.gelu(g_r)
    out = merge_branches(att, lru, g_att, g_lru, p)
    if not need_ctx:
        return out, None
    cq = mla_queries(cc_q, p, None, None)
    catt = softmax_attend(cq, ck, cv).reshape(b, -1, MLA_HEADS * V_HEAD)
    clru = (hc_f + hc_b).astype(h.dtype) * jax.nn.gelu(cg_r)
    return out, merge_branches(catt, clru, cg_att, cg_lru, p)


def clamped_swiglu(g, u):
    g = jnp.minimum(g, SWIGLU_LIMIT)
    u = jnp.clip(u, -SWIGLU_LIMIT, SWIGLU_LIMIT)
    return g * jax.nn.sigmoid(SWIGLU_ALPHA * g) * (u + 1)


def moe_ffn(h, p):
    b, n, d = h.shape
    t = b * n
    xf = h.reshape(t, d)
    logits = (xf @ p['w_router'] + p['b_router']).astype(jnp.float32)
    top_val, top_idx = lax.top_k(logits, TOP_K)
    gates = jax.nn.softmax(top_val, axis=-1)
    e_flat = top_idx.reshape(-1)
    tok_flat = jnp.repeat(jnp.arange(t, dtype=jnp.int32), TOP_K)
    w_flat = gates.reshape(-1)
    order = jnp.argsort(e_flat)
    e_sorted = e_flat[order]
    counts = jnp.bincount(e_flat, length=N_EXPERTS)
    padded = ((counts + MOE_BLOCK - 1) // MOE_BLOCK) * MOE_BLOCK
    start = jnp.cumsum(counts) - counts
    pad_end = jnp.cumsum(padded)
    pad_start = pad_end - padded
    n_assign = t * TOP_K
    dest = pad_start[e_sorted] + (jnp.arange(n_assign, dtype=jnp.int32) - start[e_sorted])
    n_blocks = (n_assign + MOE_BLOCK - 1) // MOE_BLOCK + N_EXPERTS
    n_rows = n_blocks * MOE_BLOCK
    row_tok = jnp.full((n_rows,), t, jnp.int32).at[dest].set(tok_flat[order])
    row_w = jnp.zeros((n_rows,), jnp.float32).at[dest].set(w_flat[order])
    blk_start = jnp.arange(n_blocks, dtype=jnp.int32) * MOE_BLOCK
    blk_expert = jnp.minimum(jnp.searchsorted(pad_end, blk_start, side='right'), N_EXPERTS - 1)
    x_pad = jnp.concatenate([xf, jnp.zeros((1, d), xf.dtype)], axis=0)
    rows = x_pad[row_tok].reshape(n_blocks, MOE_BLOCK, d)

    def expert_block(args):
        xb, e = args
        g = xb @ p['w_exp_gate'][e] + p['b_exp_gate'][e]
        u = xb @ p['w_exp_up'][e] + p['b_exp_up'][e]
        return clamped_swiglu(g, u) @ p['w_exp_down'][e] + p['b_exp_down'][e]

    yb = lax.map(expert_block, (rows, blk_expert)).reshape(n_rows, d)
    y = jnp.zeros((t + 1, d), h.dtype).at[row_tok].add(yb * row_w[:, None].astype(h.dtype))
    return y[:t].reshape(b, n, d)


def setup_inputs(seed: int = 0) -> dict:
    key = jax.random.key(seed)
    ks = iter(jax.random.split(key, 40))
    f32 = jnp.float32
    L, D, E = DEPTH, D_MODEL, N_EXPERTS

    def nrm(shape, scale):
        return jax.random.normal(next(ks), shape, f32) * scale

    u = jax.random.uniform(next(ks), (L, 2, LRU_WIDTH), f32, 0.9, 0.999)
    s = u ** (1.0 / LRU_C)
    lam = jnp.log(s) - jnp.log1p(-s)
    return {
        'x': nrm((BATCH, SEQ, D), 1.0),
        'c': nrm((BATCH, D), 1.0),
        'ctx': nrm((BATCH, CTX_LEN, D), 1.0),
        'c_ctx': nrm((D,), 1.0),
        'w_ada': nrm((L, D, 6 * D), 0.5 * D ** -0.5),
        'b_ada': nrm((L, 6 * D), 0.01),
        'norm_mix': 1.0 + nrm((L, D), 0.01),
        'norm_ffn': 1.0 + nrm((L, D), 0.01),
        'w_in': nrm((L, D, D_IN), D ** -0.5),
        'b_branch_gate': nrm((L, 2 * D), 0.01),
        'q_norm': 1.0 + nrm((L, Q_LORA), 0.01),
        'w_uq': nrm((L, Q_LORA, MLA_HEADS * QK_DIM), Q_LORA ** -0.5),
        'kv_norm': 1.0 + nrm((L, KV_LORA), 0.01),
        'w_ukv': nrm((L, KV_LORA, MLA_HEADS * (QK_NOPE + V_HEAD)), KV_LORA ** -0.5),
        'w_o_attn': nrm((L, MLA_HEADS * V_HEAD, D), (MLA_HEADS * V_HEAD) ** -0.5),
        'conv_w': nrm((L, CONV_W, LRU_WIDTH), CONV_W ** -0.5),
        'conv_b': nrm((L, LRU_WIDTH), 0.01),
        'lru_w_a': nrm((L, 2, LRU_BLOCKS, LRU_BW, LRU_BW), LRU_BW ** -0.5),
        'lru_b_a': nrm((L, 2, LRU_WIDTH), 0.01),
        'lru_w_x': nrm((L, 2, LRU_BLOCKS, LRU_BW, LRU_BW), LRU_BW ** -0.5),
        'lru_b_x': nrm((L, 2, LRU_WIDTH), 0.01),
        'lru_lambda': lam,
        'w_o_lru': nrm((L, LRU_WIDTH, D), LRU_WIDTH ** -0.5),
        'w_out': nrm((L, D, D), D ** -0.5),
        'w_router': nrm((L, D, E), D ** -0.5),
        'b_router': nrm((L, E), 0.01),
        'w_exp_gate': nrm((L, E, D, D_FF), D ** -0.5),
        'b_exp_gate': nrm((L, E, D_FF), 0.01),
        'w_exp_up': nrm((L, E, D, D_FF), D ** -0.5),
        'b_exp_up': nrm((L, E, D_FF), 0.01),
        'w_exp_down': nrm((L, E, D_FF, D), D_FF ** -0.5),
        'b_exp_down': nrm((L, E, D), 0.01),
        'final_norm': 1.0 + nrm((D,), 0.01),
    }


def reference(x, c, ctx, c_ctx, w_ada, b_ada, norm_mix, norm_ffn, w_in, b_branch_gate,
              q_norm, w_uq, kv_norm, w_ukv, w_o_attn, conv_w, conv_b, lru_w_a, lru_b_a,
              lru_w_x, lru_b_x, lru_lambda, w_o_lru, w_out, w_router, b_router,
              w_exp_gate, b_exp_gate, w_exp_up, b_exp_up, w_exp_down, b_exp_down, final_norm):
    n_ctx = ctx.shape[1]
    cos, sin = axial_rope_tables(x.shape[1])
    cos = cos.astype(x.dtype)
    sin = sin.astype(x.dtype)
    x_lat, x_ctx = x, ctx
    for l in range(DEPTH):
        need_ctx = l < DEPTH - 1
        p = {
            'w_in': w_in[l], 'b_branch_gate': b_branch_gate[l],
            'q_norm': q_norm[l], 'w_uq': w_uq[l], 'kv_norm': kv_norm[l], 'w_ukv': w_ukv[l],
            'w_o_attn': w_o_attn[l], 'conv_w': conv_w[l], 'conv_b': conv_b[l],
            'lru_w_a': lru_w_a[l], 'lru_b_a': lru_b_a[l], 'lru_w_x': lru_w_x[l],
            'lru_b_x': lru_b_x[l], 'lru_lambda': lru_lambda[l], 'w_o_lru': w_o_lru[l],
            'w_out': w_out[l], 'w_router': w_router[l], 'b_router': b_router[l],
            'w_exp_gate': w_exp_gate[l], 'b_exp_gate': b_exp_gate[l],
            'w_exp_up': w_exp_up[l], 'b_exp_up': b_exp_up[l],
            'w_exp_down': w_exp_down[l], 'b_exp_down': b_exp_down[l],
        }
        sh1, sc1, g1, sh2, sc2, g2 = adaln(c, w_ada[l], b_ada[l])
        csh1, csc1, cg1, csh2, csc2, cg2 = adaln(c_ctx[None, :], w_ada[l], b_ada[l])
        h = modulate(rmsnorm(x_lat, norm_mix[l]), sh1, sc1)
        hc = modulate(rmsnorm(x_ctx, norm_mix[l]), csh1, csc1)
        o, oc = token_mixer(h, hc, p, cos, sin, need_ctx)
        x_lat = x_lat + g1 * o
        h = modulate(rmsnorm(x_lat, norm_ffn[l]), sh2, sc2)
        if need_ctx:
            x_ctx = x_ctx + cg1 * oc
            hc = modulate(rmsnorm(x_ctx, norm_ffn[l]), csh2, csc2)
            y = moe_ffn(jnp.concatenate([hc, h], axis=1), p)
            x_ctx = x_ctx + cg2 * y[:, :n_ctx]
            y = y[:, n_ctx:]
        else:
            y = moe_ffn(h, p)
        x_lat = x_lat + g2 * y
    return rmsnorm(x_lat, final_norm)
```

```cpp
#include <hip/hip_runtime.h>
#include <cstdio>
#include <cstdint>

#ifndef G1_F8
#define G1_F8 0
#endif
#ifndef PG8_SP2
#define PG8_SP2 true
#endif
#ifndef MRG_F8
#define MRG_F8 0
#endif
#ifndef Y_F8
#define Y_F8 1
#endif
#ifndef MOE2_F8
#define MOE2_F8 1
#endif
#ifndef MULTI_LAUNCH
#define MULTI_LAUNCH 0
#endif

#define LAS __attribute__((address_space(3)))
typedef unsigned short bf16_t;
typedef short bf16x8 __attribute__((ext_vector_type(8)));
typedef short s16x4 __attribute__((ext_vector_type(4)));
typedef float f32x4 __attribute__((ext_vector_type(4)));
typedef float f32x2 __attribute__((ext_vector_type(2)));
typedef float f32x16 __attribute__((ext_vector_type(16)));
typedef unsigned u32x4 __attribute__((ext_vector_type(4)));
typedef unsigned u32x2 __attribute__((ext_vector_type(2)));

constexpr int D = 1024, SEQ = 8192, CTXL = 256;
constexpr int TLAT = 16384, T = 16896;
constexpr int DIN = 4544, DINP = 4608;
constexpr int ZC_CQ = 0, ZC_CKV = 256, ZC_KPE = 384, ZC_XR = 448, ZC_GR = 1472, ZC_GA = 2496, ZC_GL = 3520;
constexpr int NQ = 1536, NKV = 2048;
constexpr int NE = 32, NSLOT = 75776;
constexpr float EPS = 1e-6f;
constexpr int NCHUNK = T / 64;
constexpr int KTOT = CTXL + SEQ;

constexpr size_t MiB = 1u << 20;
constexpr size_t WS_CTL = 0, CTL_BYTES = 1 * MiB;
constexpr size_t WS_MOD = 1 * MiB;
constexpr size_t WS_TAB = 1 * MiB + 256 * 1024;
constexpr size_t WS_LRUC = 1 * MiB + 320 * 1024;
constexpr size_t WS_SSQ = 2 * MiB;
constexpr size_t WS_SUM = 3 * MiB;
constexpr size_t WS_CAR = 8 * MiB;
constexpr size_t WS_TOKE = 11 * MiB;
constexpr size_t WS_TOKW = 11 * MiB + 512 * 1024;
constexpr size_t WS_SLOTW = 12 * MiB;
constexpr size_t WS_WL = 16 * MiB, WL_STRIDE = 20 * MiB;
constexpr size_t OFF_WIN = 0, OFF_WUQ = 9 * MiB, OFF_WUKV = 10 * MiB, OFF_WM = 11 * MiB, OFF_WOUT = 15 * MiB, OFF_WR = 17 * MiB, OFF_LW = 17 * MiB + 512 * 1024;
constexpr size_t WS_WGU = 56 * MiB, WGU_STRIDE = 128 * MiB;
constexpr size_t WS_WD = 312 * MiB, WD_STRIDE = 64 * MiB;
constexpr size_t WS_X = 440 * MiB;
constexpr size_t WS_H = 506 * MiB;
constexpr size_t WS_Z = 539 * MiB;
constexpr size_t WS_Q = 688 * MiB;
constexpr size_t WS_KV = 738 * MiB;
constexpr size_t WS_KPE = 804 * MiB;
constexpr size_t WS_AL = 807 * MiB;
constexpr size_t WS_M = 873 * MiB;
constexpr size_t WS_XS = 539 * MiB;
constexpr size_t WS_ACT = 688 * MiB;
constexpr size_t WS_LIST = 906 * MiB;
constexpr int LCAP = T + 256;
constexpr size_t WS_K8 = 911 * MiB;
constexpr size_t WS_END = 928 * MiB;
constexpr int CW_BAR = 4096, CW_CNT = 8192;

constexpr int LDS_BYTES = 163840, MISC_OFF = 163584;

__device__ __forceinline__ unsigned cvt_pk_bf16(float lo, float hi) { unsigned r; asm volatile("v_cvt_pk_bf16_f32 %0, %1, %2" : "=v"(r) : "v"(lo), "v"(hi)); return r; }
typedef int v8i __attribute__((ext_vector_type(8)));
typedef int i32x4 __attribute__((ext_vector_type(4)));
__device__ __forceinline__ unsigned pack_fp8x4(float a, float b, float c, float d) { int w = __builtin_amdgcn_cvt_pk_fp8_f32(a, b, 0, false); w = __builtin_amdgcn_cvt_pk_fp8_f32(c, d, w, true); return (unsigned)w; }
__device__ __forceinline__ unsigned pack_fp8x4_sat(float a, float b, float c, float d) {
    return pack_fp8x4(__builtin_amdgcn_fmed3f(a, -448.f, 448.f), __builtin_amdgcn_fmed3f(b, -448.f, 448.f), __builtin_amdgcn_fmed3f(c, -448.f, 448.f), __builtin_amdgcn_fmed3f(d, -448.f, 448.f)); }
constexpr float F8_WSCALE = 32.f, F8_WINV = 1.f / 32.f;
constexpr float F8_SA = 64.f, F8_SL = 1.f, F8_SM = 4.f;
__device__ __forceinline__ float bf_lo(unsigned w) { return __uint_as_float(w << 16); }
__device__ __forceinline__ float bf_hi(unsigned w) { return __uint_as_float(w & 0xffff0000u); }
__device__ __forceinline__ f32x4 bf4_to_f32x4(u32x2 w) { return (f32x4){bf_lo(w.x), bf_hi(w.x), bf_lo(w.y), bf_hi(w.y)}; }
__device__ __forceinline__ float bf1(bf16_t h) { return __uint_as_float(((unsigned)h) << 16); }
constexpr float LOG2E = 1.4426950408889634f;
__device__ __forceinline__ float fast_exp(float x) { return __builtin_amdgcn_exp2f(x * 1.4426950408889634f); }
__device__ __forceinline__ float sigmoidf_(float x) { return __builtin_amdgcn_rcpf(1.f + fast_exp(-x)); }
__device__ __forceinline__ float gelu_tanh(float x) { const float z = 0.7978845608028654f * (x + 0.044715f * x * x * x); return x * sigmoidf_(2.f * z); }
__device__ __forceinline__ float wave_sum(float v) {
#pragma unroll
    for (int o = 1; o < 64; o <<= 1) v += __shfl_xor(v, o);
    return v;
}

#define GAS __attribute__((address_space(1)))
#define CAS __attribute__((address_space(4)))
typedef const float* cfptr;
typedef const cfptr CAS* InArr;
template <class P> __device__ __forceinline__ P* opq(P* p) {
    const unsigned long long v = (unsigned long long)p; unsigned lo = __builtin_amdgcn_readfirstlane((unsigned)v), hi = __builtin_amdgcn_readfirstlane((unsigned)(v >> 32));
    asm volatile("" : "+s"(lo), "+s"(hi));
    return (P*)(GAS char*)(((unsigned long long)hi << 32) | lo);
}
__device__ __forceinline__ InArr opq_in(InArr p) {
    const unsigned long long v = (unsigned long long)p; unsigned lo = __builtin_amdgcn_readfirstlane((unsigned)v), hi = __builtin_amdgcn_readfirstlane((unsigned)(v >> 32));
    asm volatile("" : "+s"(lo), "+s"(hi));
    return (InArr)(((unsigned long long)hi << 32) | lo);
}
__device__ __forceinline__ const float* inp(InArr in, int i) { return (const float*)(const GAS float*)in[i]; }
__device__ __forceinline__ int opq_v(int v) { asm volatile("" : "+v"(v)); return v; }
__device__ __forceinline__ int opq_i(int v) { v = __builtin_amdgcn_readfirstlane(v); asm volatile("" : "+s"(v)); return v; }

#define XB_TMO      128
#define XB_XCNT(j)  (256  + 64 * (j))
#define XB_XSUB(j)  (1280 + 64 * (j))
#define XB_XGEN(j)  (2304 + 64 * (j))
#define XB_TOP      3328
#define XB_TOPGEN   3392
#define XCD_BAR_WORDS 3456
#define XB_SPIN_CAP (1u << 22)
__device__ __forceinline__ unsigned xb_ld(unsigned* p)              { return __hip_atomic_load(p, __ATOMIC_RELAXED, __HIP_MEMORY_SCOPE_AGENT); }
__device__ __forceinline__ unsigned xb_add(unsigned* p, unsigned v) { return __hip_atomic_fetch_add(p, v, __ATOMIC_RELAXED, __HIP_MEMORY_SCOPE_AGENT); }
__device__ __forceinline__ unsigned xb_xcc_id() { return (unsigned)__builtin_amdgcn_s_getreg((3 << 11) | 20) & 0xFu; }
#define XB_SPIN(cond, bar) do { unsigned _sp = 0; while (cond) { __builtin_amdgcn_s_sleep(1); \
    if ((++_sp & 255u) == 0u) { if (xb_ld(&(bar)[XB_TMO])) break; if (_sp > XB_SPIN_CAP) { atomicAdd(&(bar)[XB_TMO], 1u); break; } } } } while (0)
struct XcdBarrier { unsigned* bar; unsigned x; volatile LAS unsigned* st; };
__device__ __forceinline__ XcdBarrier xcd_barrier_post(unsigned* bar, volatile LAS unsigned* st) {
    XcdBarrier b; b.bar = bar; b.x = xb_xcc_id(); b.st = st;
    if (threadIdx.x == 0) (void)xb_add(&bar[XB_XCNT(b.x)], 1u);
    return b;
}
__device__ __forceinline__ void xcd_barrier_complete(unsigned* bar, unsigned x, unsigned& nloc, unsigned& nx) {
    const unsigned G = gridDim.x * gridDim.y * gridDim.z;
    unsigned sum, cnt, mine, sp = 0u;
    for (;;) {
        sum = 0u; cnt = 0u; mine = 0u;
#pragma unroll 1
        for (unsigned j = 0; j < 16; ++j) { const unsigned c = xb_ld(&bar[XB_XCNT(j)]); sum += c; cnt += (c > 0u) ? 1u : 0u; mine = (j == x) ? c : mine; }
        if (sum == G) break;
        __builtin_amdgcn_s_sleep(1);
        if ((++sp & 255u) == 0u) { if (xb_ld(&bar[XB_TMO])) break; if (sp > XB_SPIN_CAP) { atomicAdd(&bar[XB_TMO], 1u); break; } }
    }
    nloc = mine > 0u ? mine : 1u; nx = cnt > 0u ? cnt : 1u;
}
__device__ __forceinline__ void xcd_barrier(const XcdBarrier& b) {
    asm volatile("s_waitcnt vmcnt(0)" ::: "memory");
    __syncthreads();
    if (threadIdx.x == 0) {
        unsigned* bar = b.bar;
        __builtin_amdgcn_s_waitcnt(0);
        unsigned nloc = b.st[0], nx = b.st[1];
        if (nloc == 0u) { xcd_barrier_complete(bar, b.x, nloc, nx); b.st[0] = nloc; b.st[1] = nx; }
        const unsigned old = xb_add(&bar[XB_XSUB(b.x)], 1u);
        const unsigned gen = old / nloc;
        if (old + 1u == (gen + 1u) * nloc) {
            __builtin_amdgcn_fence(__ATOMIC_RELEASE, "agent");
            asm volatile("s_waitcnt vmcnt(0)" ::: "memory");
            const unsigned og = xb_add(&bar[XB_TOP], 1u);
            const unsigned tg = og / nx;
            if (og + 1u == (tg + 1u) * nx) xb_add(&bar[XB_TOPGEN], 1u);
            else XB_SPIN(xb_ld(&bar[XB_TOPGEN]) == tg, bar);
            __builtin_amdgcn_fence(__ATOMIC_ACQUIRE, "agent");
            xb_add(&bar[XB_XGEN(b.x)], 1u);
            asm volatile("s_waitcnt vmcnt(0)" ::: "memory");
        } else {
            XB_SPIN(xb_ld(&bar[XB_XGEN(b.x)]) == gen, bar);
            __builtin_amdgcn_fence(__ATOMIC_ACQUIRE, "agent");
            asm volatile("s_waitcnt vmcnt(0)" ::: "memory");
        }
    }
    __syncthreads();
}

namespace pg8 {
constexpr int BM = 256, BK = 64, HALF = 128, HTB = HALF * BK * 2, STAGE_BYTES = 8 * HTB, NXCD = 8, WGM = 8;
__host__ __device__ __forceinline__ int lds_byte(int r, int c) { const int st = (r >> 4) * 2 + (c >> 5), rr = r & 15, cc = c & 31, ob = rr * 64 + cc * 2; return st * 1024 + (ob ^ (((ob >> 9) & 1) << 5)); }
__host__ __device__ __forceinline__ void stage_rc(int b, int& R, int& C) { const int st = b / 1024, sb = b % 1024, swz = sb ^ (((sb >> 9) & 1) << 5); R = (st >> 1) * 16 + swz / 64; C = (st & 1) * 32 + (swz % 64) / 2; }
__host__ __device__ __forceinline__ void stage_rc8(int b, int& R, int& C) { const int st = b / 1024, sb = b % 1024, swz = sb ^ (((sb >> 9) & 1) << 5); R = (st >> 1) * 16 + swz / 64; C = (((swz % 64) / 16) * 32 + (st & 1) * 16) / 2; }
__device__ __forceinline__ v8i cat8(bf16x8 a, bf16x8 b) { const i32x4 x = __builtin_bit_cast(i32x4, a), y = __builtin_bit_cast(i32x4, b); return __builtin_shufflevector(x, y, 0, 1, 2, 3, 4, 5, 6, 7); }
__host__ __device__ __forceinline__ int perm32(int rho) { const int n = rho >> 4, i = rho & 15; return 8 * (i >> 2) + 4 * n + (i & 3); }
struct Unit { int pm, pn, aux, e, rl; };

template <bool GATHER_> struct TileOrderT {
    static constexpr bool GATHER = GATHER_;
    const char* A; const char* B; int lda, ldb;
    int nM, nN, nwg, G, c, dual, koff;
    __device__ void init(const void* A_, int lda_, const void* B_, int ldb_, int nM_, int nN_, int G_, int c_, int dual_ = 0, int koff_ = 0) {
        A = (const char*)A_; B = (const char*)B_; lda = lda_; ldb = ldb_; nM = nM_; nN = nN_; nwg = nM * nN; G = G_; c = c_; dual = dual_; koff = koff_; }
    __device__ __forceinline__ bool next(int i, Unit& u) const {
        const int ti = dual ? (i >> 1) : i; u.aux = dual ? (i & 1) : 0; u.e = 0; u.rl = 0;
        const long L = (long)ti * G + c; if (L >= nwg) return false;
        int wgid = (int)L; { const int q = nwg / NXCD, r = nwg % NXCD, xcd = wgid % NXCD, off = wgid / NXCD; wgid = (xcd < r ? xcd * (q + 1) : r * (q + 1) + (xcd - r) * q) + off; }
        const int nig = WGM * nN, gid = wgid / nig, fm = gid * WGM, gsz = (nM - fm) < WGM ? (nM - fm) : WGM;
        u.pm = fm + ((wgid % nig) % gsz); u.pn = (wgid % nig) / gsz; return true;
    }
    __device__ __forceinline__ const char* a_ptr(const Unit& u) const { return GATHER ? A : A + ((size_t)u.pm * BM * lda + (size_t)u.aux * koff) * 2; }
    __device__ __forceinline__ const char* b_ptr(const Unit& u) const { return B + ((size_t)u.pn * BM * ldb + (size_t)u.aux * koff) * 2; }
    __device__ __forceinline__ void gather(int ui, const int (&R)[2], const int (&Cc)[2], unsigned (&va)[2][2]) const {
        Unit u; (void)next(ui, u);
#pragma unroll
        for (int h = 0; h < 2; ++h)
#pragma unroll
            for (int i = 0; i < 2; ++i) va[h][i] = (unsigned)((u.pm * BM + h * 128 + R[i]) * lda + Cc[i] + u.aux * koff) * 2u;
    }
};
typedef TileOrderT<false> TileOrder;
template <bool GATHER_> struct MoeOrder {
    static constexpr bool GATHER = GATHER_;
    const char* A; const char* B; int lda, ldb; const LAS int* tp; int NT, G, c, total; const u32x2* list;
    __device__ __forceinline__ bool next(int i, Unit& u) const {
        const int L = i * G + c; if (L >= total) return false;
        int e = 0;
#pragma unroll 8
        for (int k = 0; k < 32; ++k) e += (tp[k + 1] * NT <= L) ? 1 : 0;
        const int t0 = tp[e], nte = tp[e + 1] - t0, rem = L - t0 * NT, pnl = rem / nte, rtl = rem - pnl * nte;
        u.pm = __builtin_amdgcn_readfirstlane(t0 + rtl); u.pn = __builtin_amdgcn_readfirstlane(e * NT + pnl); u.aux = 0; u.e = __builtin_amdgcn_readfirstlane(e); u.rl = __builtin_amdgcn_readfirstlane(rtl); return true;
    }
    __device__ __forceinline__ const char* a_ptr(const Unit& u) const { return GATHER ? A : A + (size_t)u.pm * BM * lda * 2; }
    __device__ __forceinline__ const char* b_ptr(const Unit& u) const { return B + (size_t)u.pn * BM * ldb * 2; }
    const LAS int* tokl;
    __device__ __forceinline__ void gather(int ui, const int (&R)[2], const int (&Cc)[2], unsigned (&va)[2][2]) const {
#pragma unroll
        for (int h = 0; h < 2; ++h)
#pragma unroll
            for (int i = 0; i < 2; ++i) va[h][i] = (unsigned)(tokl[ui * 256 + h * 128 + R[i]] * lda + Cc[i]) * 2u;
    }
    __device__ __forceinline__ void build_lists(LAS int* tl, int tid0) {
        const int tid = opq_v(tid0);
        for (int i = 0; ; i += 3) { Unit u[3]; bool ok[3]; int v[3];
#pragma unroll
            for (int j = 0; j < 3; ++j) { ok[j] = next(i + j, u[j]); v[j] = 0;
                if (ok[j] && tid < 256) { const int pos = u[j].rl * 256 + tid;
                    v[j] = list ? ((pos < tp[33 + u[j].e]) ? (int)((const unsigned*)(list + (size_t)u[j].e * LCAP + pos))[0] : 0) : u[j].pm * 256 + tid; } }
#pragma unroll
            for (int j = 0; j < 3; ++j) if (ok[j] && tid < 256) tl[(i + j) * 256 + tid] = v[j];
            if (!ok[2]) break; }
        tokl = tl; __syncthreads();
    }
};

template <class Epi, class Sched, bool F8 = false>
__device__ __forceinline__ void gemm_phase(LAS unsigned char* lds, int K, const Sched& S, const Epi& E) {
    const int tid = opq_v(threadIdx.x), wid = __builtin_amdgcn_readfirstlane(tid >> 6), lane = tid & 63, wr = wid >> 2, wc = wid & 3, fr = lane & 15, fq = lane >> 4;
    const int nt = K / BK;
    unsigned voffB[2], vaC[2][2], vaN[2][2]; int sR[2], sC[2];
    const size_t kstep = (size_t)(BK * 2);
    const size_t hstepB = (size_t)HALF * S.ldb * 2;
#pragma unroll
    for (int i = 0; i < 2; ++i) { int R, C; if (F8) stage_rc8(tid * 16 + i * 8192, R, C); else stage_rc(tid * 16 + i * 8192, R, C); const int Rb = Epi::PERM ? ((R & ~31) + perm32(R & 31)) : R; sR[i] = R; sC[i] = C;
        voffB[i] = (unsigned)(Rb * S.ldb + C) * 2u;
        vaC[0][i] = (unsigned)(R * S.lda + C) * 2u; vaC[1][i] = 0u; vaN[0][i] = 0u; vaN[1][i] = 0u; }
    const unsigned hstepA = Sched::GATHER ? 0u : (unsigned)HALF * (unsigned)S.lda * 2u;
    const unsigned ldsw = (unsigned)wid * 1024u;
    const int aoff = lds_byte(wr * 64 + fr, fq * 8), boff = lds_byte(wc * 32 + fr, fq * 8);
#define PG8_SA(b, h) (((b) * 2 + (h)) * HTB)
#define PG8_SB(b, h) ((4 + (b) * 2 + (h)) * HTB)
#define PG8_STAGE(bufoff, gbase, voff) do { _Pragma("unroll") for (int _i = 0; _i < 2; ++_i) \
        __builtin_amdgcn_global_load_lds((const unsigned*)((const char*)(gbase) + (voff)[_i]), (LAS unsigned*)(lds + (bufoff) + ldsw + _i * 8192), 16, 0, 0); } while (0)
#define PG8_STAGEA(bufoff, gbase, va, h) do { _Pragma("unroll") for (int _i = 0; _i < 2; ++_i) \
        __builtin_amdgcn_global_load_lds((const unsigned*)((const char*)(gbase) + (Sched::GATHER ? (va)[h][_i] : (va)[0][_i] + (h) * hstepA)), (LAS unsigned*)(lds + (bufoff) + ldsw + _i * 8192), 16, 0, 0); } while (0)
#define PG8_LDA(dst, b, h) do { _Pragma("unroll") for (int m = 0; m < 4; ++m) _Pragma("unroll") for (int k = 0; k < 2; ++k) dst[m][k] = *(const LAS bf16x8*)(lds + PG8_SA(b, h) + aoff + m * 2048 + k * 1024); } while (0)
#define PG8_LDB(dst, b, h) do { _Pragma("unroll") for (int n = 0; n < 2; ++n) _Pragma("unroll") for (int k = 0; k < 2; ++k) dst[n][k] = *(const LAS bf16x8*)(lds + PG8_SB(b, h) + boff + n * 2048 + k * 1024); } while (0)
#define PG8_MMA(ai, bj, At, Bt) do { __builtin_amdgcn_s_setprio(1); _Pragma("unroll") for (int m = 0; m < 4; ++m) _Pragma("unroll") for (int n = 0; n < 2; ++n) { \
        if constexpr (F8) acc[ai][bj][m][n] = __builtin_amdgcn_mfma_scale_f32_16x16x128_f8f6f4(cat8(Bt[n][0], Bt[n][1]), cat8(At[m][0], At[m][1]), acc[ai][bj][m][n], 0, 0, 0, 127, 0, 127); \
        else { _Pragma("unroll") for (int k = 0; k < 2; ++k) acc[ai][bj][m][n] = __builtin_amdgcn_mfma_f32_16x16x32_bf16(Bt[n][k], At[m][k], acc[ai][bj][m][n], 0, 0, 0); } } \
        __builtin_amdgcn_s_setprio(0); } while (0)
#define PG8_WAIT_V(n) asm volatile("s_waitcnt vmcnt(" #n ")" ::: "memory")
#define PG8_WAIT_L(n) asm volatile("s_waitcnt lgkmcnt(" #n ")" ::: "memory")
#define PG8_BAR __builtin_amdgcn_s_barrier()
#define PG8_SCHED __builtin_amdgcn_sched_barrier(0)
    Unit cur, nxt; int ui = 0;
    if (!S.next(0, cur)) return;
    f32x4 acc[2][2][4][2];
#pragma unroll
    for (int a = 0; a < 2; ++a)
#pragma unroll
        for (int b = 0; b < 2; ++b)
#pragma unroll
            for (int m = 0; m < 4; ++m)
#pragma unroll
                for (int n = 0; n < 2; ++n) acc[a][b][m][n] = (f32x4){0.f, 0.f, 0.f, 0.f};
    bf16x8 At[4][2], B0[2][2], B1[2][2];
    const char* cA = S.a_ptr(cur); const char* cB = S.b_ptr(cur);
    if constexpr (Sched::GATHER) { S.gather(0, sR, sC, vaC);
#pragma unroll
        for (int h = 0; h < 2; ++h)
#pragma unroll
            for (int i = 0; i < 2; ++i) asm volatile("" : "+v"(vaC[h][i])); }
    constexpr bool SP2 = PG8_SP2;
    if constexpr (SP2) {
        PG8_STAGE(PG8_SB(0, 0), cB, voffB); PG8_STAGE(PG8_SB(0, 1), cB + hstepB, voffB); PG8_STAGEA(PG8_SA(0, 0), cA, vaC, 0); PG8_STAGEA(PG8_SA(0, 1), cA, vaC, 1);
        if (wr == 1) PG8_BAR;
        PG8_WAIT_V(2); PG8_BAR;
        PG8_STAGE(PG8_SB(1, 0), cB + kstep, voffB); PG8_STAGEA(PG8_SA(1, 0), cA + kstep, vaC, 0); PG8_STAGE(PG8_SB(1, 1), cB + hstepB + kstep, voffB);
        PG8_WAIT_V(6); PG8_BAR;
    } else {
    PG8_STAGE(PG8_SB(0, 0), cB, voffB); PG8_STAGEA(PG8_SA(0, 0), cA, vaC, 0); PG8_STAGE(PG8_SB(0, 1), cB + hstepB, voffB); PG8_STAGEA(PG8_SA(0, 1), cA, vaC, 1);
    if (wr == 1) PG8_BAR;
    PG8_WAIT_V(4); PG8_BAR;
    PG8_STAGE(PG8_SB(1, 0), cB + kstep, voffB); PG8_STAGEA(PG8_SA(1, 0), cA + kstep, vaC, 0); PG8_STAGE(PG8_SB(1, 1), cB + hstepB + kstep, voffB);
    PG8_WAIT_V(6); PG8_BAR;
    }
    for (;;) {
        const bool has_next = S.next(ui + 1, nxt);
        const char* nA = has_next ? S.a_ptr(nxt) : cA; const char* nB = has_next ? S.b_ptr(nxt) : cB;
        if constexpr (Sched::GATHER) { if (has_next) S.gather(ui + 1, sR, sC, vaN);
            else {
#pragma unroll
                for (int h = 0; h < 2; ++h)
#pragma unroll
                    for (int i = 0; i < 2; ++i) vaN[h][i] = vaC[h][i]; } }
        for (int t = 0; t < nt; t += 2) {
            const bool last = (t == nt - 2);
            const char* a1 = cA + (size_t)(t + 1) * kstep;
            const char* a2 = last ? nA : cA + (size_t)(t + 2) * kstep; const char* b2 = last ? nB : cB + (size_t)(t + 2) * kstep;
            const char* a3 = a2 + kstep; const char* b3 = b2 + kstep;
            if constexpr (SP2) {
            PG8_LDB(B0, 0, 0); PG8_LDB(B1, 0, 1); PG8_SCHED; PG8_LDA(At, 0, 0); PG8_STAGEA(PG8_SA(1, 1), a1, vaC, 1);
            if constexpr (Sched::GATHER) { if (last) {
#pragma unroll
                for (int h = 0; h < 2; ++h)
#pragma unroll
                    for (int i = 0; i < 2; ++i) vaC[h][i] = vaN[h][i]; } }
            PG8_WAIT_V(8); PG8_WAIT_L(0); PG8_BAR; PG8_MMA(0, 0, At, B0); PG8_MMA(0, 1, At, B1); PG8_BAR; PG8_SCHED;
            PG8_LDA(At, 0, 1); PG8_STAGE(PG8_SB(0, 0), b2, voffB); PG8_STAGE(PG8_SB(0, 1), b2 + hstepB, voffB); PG8_STAGEA(PG8_SA(0, 0), a2, vaC, 0);
            PG8_WAIT_V(8); PG8_WAIT_L(0); PG8_BAR; PG8_MMA(1, 0, At, B0); PG8_MMA(1, 1, At, B1); PG8_BAR; PG8_SCHED;
            PG8_LDB(B0, 1, 0); PG8_LDB(B1, 1, 1); PG8_SCHED; PG8_LDA(At, 1, 0); PG8_STAGEA(PG8_SA(0, 1), a2, vaC, 1);
            PG8_WAIT_V(8); PG8_WAIT_L(0); PG8_BAR; PG8_MMA(0, 0, At, B0); PG8_MMA(0, 1, At, B1); PG8_BAR; PG8_SCHED;
            PG8_LDA(At, 1, 1); PG8_STAGE(PG8_SB(1, 0), b3, voffB); PG8_STAGE(PG8_SB(1, 1), b3 + hstepB, voffB); PG8_STAGEA(PG8_SA(1, 0), a3, vaC, 0);
            PG8_WAIT_V(8); PG8_WAIT_L(0); PG8_BAR; PG8_MMA(1, 0, At, B0); PG8_MMA(1, 1, At, B1); PG8_BAR; PG8_SCHED;
            } else {
            PG8_LDB(B0, 0, 0); PG8_SCHED; PG8_LDA(At, 0, 0); PG8_STAGEA(PG8_SA(1, 1), a1, vaC, 1);
            if constexpr (Sched::GATHER) { if (last) {
#pragma unroll
                for (int h = 0; h < 2; ++h)
#pragma unroll
                    for (int i = 0; i < 2; ++i) vaC[h][i] = vaN[h][i]; } }
            PG8_WAIT_L(8); PG8_BAR; PG8_WAIT_L(0); PG8_MMA(0, 0, At, B0); PG8_BAR; PG8_SCHED;
            PG8_LDB(B1, 0, 1); PG8_STAGE(PG8_SB(0, 0), b2, voffB);
            PG8_BAR; PG8_WAIT_L(0); PG8_MMA(0, 1, At, B1); PG8_BAR;
            PG8_LDA(At, 0, 1); PG8_STAGEA(PG8_SA(0, 0), a2, vaC, 0);
            PG8_BAR; PG8_WAIT_L(0); PG8_MMA(1, 0, At, B0); PG8_BAR; PG8_SCHED;
            PG8_STAGE(PG8_SB(0, 1), b2 + hstepB, voffB);
            PG8_WAIT_V(6); PG8_BAR; PG8_MMA(1, 1, At, B1); PG8_BAR;
            PG8_LDB(B0, 1, 0); PG8_SCHED; PG8_LDA(At, 1, 0); PG8_STAGEA(PG8_SA(0, 1), a2, vaC, 1);
            PG8_WAIT_L(8); PG8_BAR; PG8_WAIT_L(0); PG8_MMA(0, 0, At, B0); PG8_BAR; PG8_SCHED;
            PG8_LDB(B1, 1, 1); PG8_STAGE(PG8_SB(1, 0), b3, voffB);
            PG8_BAR; PG8_WAIT_L(0); PG8_MMA(0, 1, At, B1); PG8_BAR;
            PG8_LDA(At, 1, 1); PG8_STAGEA(PG8_SA(1, 0), a3, vaC, 0);
            PG8_BAR; PG8_WAIT_L(0); PG8_MMA(1, 0, At, B0); PG8_BAR; PG8_SCHED;
            PG8_STAGE(PG8_SB(1, 1), b3 + hstepB, voffB);
            PG8_WAIT_V(6); PG8_BAR; PG8_MMA(1, 1, At, B1); PG8_BAR;
                    }
        }
        if (wr == 0) PG8_BAR;
        E(acc, cur, wr, wc, fr, fq);
        if (!has_next) break;
        if (!(Epi::DUAL && cur.aux == 0)) {
#pragma unroll
            for (int a = 0; a < 2; ++a)
#pragma unroll
                for (int b = 0; b < 2; ++b)
#pragma unroll
                    for (int m = 0; m < 4; ++m)
#pragma unroll
                        for (int n = 0; n < 2; ++n) acc[a][b][m][n] = (f32x4){0.f, 0.f, 0.f, 0.f};
        }
        cur = nxt; cA = nA; cB = nB; ++ui;
        if (wr == 1) PG8_BAR;
    }
    PG8_WAIT_V(0);
    PG8_BAR;
#undef PG8_SA
#undef PG8_SB
#undef PG8_STAGE
#undef PG8_STAGEA
#undef PG8_LDA
#undef PG8_LDB
#undef PG8_MMA
#undef PG8_WAIT_V
#undef PG8_WAIT_L
#undef PG8_BAR
#undef PG8_SCHED
}
}
using pg8::Unit;
typedef f32x4 AccT[2][2][4][2];

struct EpiZ {
    static constexpr bool PERM = true, DUAL = false;
    bf16_t* Z; float* ssq;
    __device__ __forceinline__ void operator()(AccT& acc, const Unit& u, int wr, int wc, int fr, int fq) const {
        const int row0 = u.pm * 256 + wr * 64 + fr, col0 = u.pn * 256 + wc * 32 + 8 * fq;
#pragma unroll
        for (int ai = 0; ai < 2; ++ai)
#pragma unroll
            for (int m = 0; m < 4; ++m) { bf16_t* rowp = Z + (size_t)(row0 + ai * 128 + m * 16) * DINP + col0;
#pragma unroll
                for (int bj = 0; bj < 2; ++bj) { if (G1_F8) { acc[ai][bj][m][0] *= F8_WINV; acc[ai][bj][m][1] *= F8_WINV; } const f32x4 v0 = acc[ai][bj][m][0], v1 = acc[ai][bj][m][1];
                    u32x4 w; w.x = cvt_pk_bf16(v0[0], v0[1]); w.y = cvt_pk_bf16(v0[2], v0[3]); w.z = cvt_pk_bf16(v1[0], v1[1]); w.w = cvt_pk_bf16(v1[2], v1[3]);
                    *(u32x4*)(rowp + bj * 128) = w; } }
        if (u.pn <= 1) {
#pragma unroll
            for (int ai = 0; ai < 2; ++ai)
#pragma unroll
                for (int m = 0; m < 4; ++m) { float s = 0.f;
#pragma unroll
                    for (int bj = 0; bj < 2; ++bj) { if (bj == 0 || u.pn == 0) {
#pragma unroll
                        for (int n = 0; n < 2; ++n) { const f32x4 v = acc[ai][bj][m][n]; s += (v[0] * v[0] + v[1] * v[1]) + (v[2] * v[2] + v[3] * v[3]); } } }
                    s += __shfl_xor(s, 16); s += __shfl_xor(s, 32);
                    if (fq == 0) ssq[((size_t)u.pn * T + row0 + ai * 128 + m * 16) * 4 + wc] = s; }
        }
    }
};
constexpr float ATT_QSC = 8.f * 0.07216878364870322f * 1.4426950408889634f;
struct EpiQ {
    static constexpr bool PERM = false, DUAL = false;
    bf16_t* Q; const float* ssq; const float* tab;
    __device__ __forceinline__ void operator()(AccT& acc, const Unit& u, int wr, int wc, int fr, int fq) const {
        const int rowb = u.pm * 256 + wr * 64 + fr;
        float rstd[8];
#pragma unroll
        for (int h = 0; h < 2; ++h) { f32x4 p[4];
#pragma unroll
            for (int m = 0; m < 4; ++m) p[m] = *(const f32x4*)(ssq + (size_t)(rowb + h * 128 + m * 16) * 4);
#pragma unroll
            for (int m = 0; m < 4; ++m) rstd[h * 4 + m] = __builtin_amdgcn_rsqf((p[m][0] + p[m][1] + p[m][2] + p[m][3]) * (1.f / 256.f) + EPS) * ATT_QSC; }
        const int d32_0 = (u.pn * 256 + wc * 32) % 192, d32_1 = (u.pn * 256 + 128 + wc * 32) % 192;
        const bool lat = u.pm < 64, rp = lat && (d32_0 >= 128 || d32_1 >= 128);
        const int rbj = d32_1 >= 128 ? 1 : 0, d32 = rbj ? d32_1 : d32_0;
        f32x4 tb[2][2];
#define EQ_LOAD(it_) do { const int npos_ = (rowb + ((it_) >> 2) * 128 + ((it_) & 3) * 16) & 8191, pos_ = (d32 == 128) ? (npos_ >> 6) : (npos_ & 63); \
            tb[(it_) & 1][0] = *(const f32x4*)(tab + (size_t)(pos_ * 16 + 4 * fq) * 2); tb[(it_) & 1][1] = *(const f32x4*)(tab + (size_t)(pos_ * 16 + 4 * fq) * 2 + 4); } while (0)
        if (rp) { EQ_LOAD(0); EQ_LOAD(1); }
#pragma unroll
        for (int it = 0; it < 8; ++it) {
            const int ai = it >> 2, m = it & 3, row = rowb + ai * 128 + m * 16;
            f32x4 t0, t1;
            if (rp) { t0 = tb[it & 1][0]; t1 = tb[it & 1][1]; if (it + 2 < 8) EQ_LOAD(it + 2); }
#pragma unroll
            for (int bj = 0; bj < 2; ++bj) {
                const int c32 = u.pn * 256 + bj * 128 + wc * 32;
                f32x4 x1 = acc[ai][bj][m][0] * rstd[it], x2 = acc[ai][bj][m][1] * rstd[it];
                if (rp && bj == rbj) {
                    const float cs[4] = {t0[0], t0[2], t1[0], t1[2]}, sn[4] = {t0[1], t0[3], t1[1], t1[3]};
                    f32x4 o1, o2;
#pragma unroll
                    for (int i = 0; i < 4; ++i) { o1[i] = x1[i] * cs[i] - x2[i] * sn[i]; o2[i] = x1[i] * sn[i] + x2[i] * cs[i]; }
                    x1 = o1; x2 = o2;
                }
                unsigned char* qp = (unsigned char*)Q + (size_t)row * NQ + c32 + 4 * fq;
                *(unsigned*)qp = pack_fp8x4_sat(x1[0], x1[1], x1[2], x1[3]); *(unsigned*)(qp + 16) = pack_fp8x4_sat(x2[0], x2[1], x2[2], x2[3]);
            }
        }
#undef EQ_LOAD
    }
};
struct EpiKV {
    static constexpr bool PERM = true, DUAL = false;
    bf16_t* KV; const float* ssq; unsigned char* K8;
    __device__ __forceinline__ void operator()(AccT& acc, const Unit& u, int wr, int wc, int fr, int fq) const {
        const int col0 = u.pn * 256 + wc * 32 + 8 * fq, rowb = u.pm * 256 + wr * 64 + fr;
        f32x4 p[8];
#pragma unroll
        for (int it = 0; it < 8; ++it) p[it] = *(const f32x4*)(ssq + (size_t)(rowb + (it >> 2) * 128 + (it & 3) * 16) * 4);
#pragma unroll
        for (int it = 0; it < 8; ++it) {
            const int ai = it >> 2, m = it & 3, row = rowb + ai * 128 + m * 16;
            const float rstd = __builtin_amdgcn_rsqf((p[it][0] + p[it][1] + p[it][2] + p[it][3]) * (1.f / 128.f) + EPS);
            { const f32x4 v0 = acc[ai][0][m][0] * rstd, v1 = acc[ai][0][m][1] * rstd;
              u32x2 w; w.x = pack_fp8x4_sat(v0[0], v0[1], v0[2], v0[3]); w.y = pack_fp8x4_sat(v1[0], v1[1], v1[2], v1[3]);
              *(u32x2*)(K8 + (size_t)row * 1024 + u.pn * 128 + wc * 32 + 8 * fq) = w; }
            { const f32x4 v0 = acc[ai][1][m][0] * rstd, v1 = acc[ai][1][m][1] * rstd;
              const int b = row < TLAT ? (row >> 13) : ((row - TLAT) >> 8), kidx = row < TLAT ? CTXL + (row & 8191) : ((row - TLAT) & 255);
              const int kap = kidx & 31, pos = (kidx & ~63) + 32 * ((kap >> 2) & 1) + (kap & 3) + 4 * (kap >> 3) + 16 * ((kidx >> 5) & 1);
              unsigned char* vt = (unsigned char*)KV + ((size_t)(b * 8 + u.pn) * 128 + wc * 32 + 8 * fq) * KTOT + pos;
              const unsigned w0 = pack_fp8x4_sat(v0[0], v0[1], v0[2], v0[3]), w1 = pack_fp8x4_sat(v1[0], v1[1], v1[2], v1[3]);
#pragma unroll
              for (int j = 0; j < 4; ++j) { vt[(size_t)j * KTOT] = (unsigned char)(w0 >> (8 * j)); vt[(size_t)(4 + j) * KTOT] = (unsigned char)(w1 >> (8 * j)); } }
        }
    }
};
struct EpiM {
    static constexpr bool PERM = true, DUAL = true;
    const bf16_t* Z; const float* bb; bf16_t* Mb;
    __device__ __forceinline__ void operator()(AccT& acc, const Unit& u, int wr, int wc, int fr, int fq) const {
        const int rowb = u.pm * 256 + wr * 64 + fr, colb = u.pn * 256 + wc * 32 + 8 * fq;
        const bf16_t* zb = Z + (size_t)rowb * DINP + colb;
        constexpr int PF = 4;
        u32x4 ra[PF], rl[PF];
        const bf16_t* zb2 = zb; (void)zb2; const int oa_ = __builtin_amdgcn_readfirstlane(u.aux ? ZC_GL : ZC_GA);
#define EM_LOAD(it_) do { const int o_ = (((it_) >> 2) & 1) * 128 * DINP + ((it_) & 3) * 16 * DINP + ((it_) >> 3) * 128; \
            ra[(it_) % PF] = *(const u32x4*)(zb + o_ + oa_); rl[(it_) % PF] = *(const u32x4*)(zb + o_ + ZC_GL); } while (0)
#pragma unroll
        for (int it = 0; it < PF; ++it) EM_LOAD(it);
        f32x4 b1a, b1b, b2a, b2b;
#pragma unroll
        for (int it = 0; it < 16; ++it) {
            const int bj = it >> 3, ai = (it >> 2) & 1, m = it & 3, col = colb + bj * 128, row = rowb + ai * 128 + m * 16;
            if ((it & 7) == 0) { b1a = *(const f32x4*)(bb + col); b1b = *(const f32x4*)(bb + col + 4); b2a = *(const f32x4*)(bb + 1024 + col); b2b = *(const f32x4*)(bb + 1024 + col + 4); }
            const u32x4 ga = ra[it % PF], gl = rl[it % PF];
            if (it + PF < 16) EM_LOAD(it + PF);
            const float x1[8] = {bf_lo(ga.x) + b1a[0], bf_hi(ga.x) + b1a[1], bf_lo(ga.y) + b1a[2], bf_hi(ga.y) + b1a[3], bf_lo(ga.z) + b1b[0], bf_hi(ga.z) + b1b[1], bf_lo(ga.w) + b1b[2], bf_hi(ga.w) + b1b[3]};
            const float x2[8] = {bf_lo(gl.x) + b2a[0], bf_hi(gl.x) + b2a[1], bf_lo(gl.y) + b2a[2], bf_hi(gl.y) + b2a[3], bf_lo(gl.z) + b2b[0], bf_hi(gl.z) + b2b[1], bf_lo(gl.w) + b2b[2], bf_hi(gl.w) + b2b[3]};
            if (u.aux == 0) {
#pragma unroll
                for (int e = 0; e < 8; ++e) { const float r = (1.f + fast_exp(-x2[e])) * __builtin_amdgcn_rcpf(1.f + fast_exp(-x1[e])); acc[ai][bj][m][e >> 2][e & 3] *= r * (MRG_F8 ? F8_SL / F8_SA : 1.f); }
            } else {
                float o[8];
#pragma unroll
                for (int e = 0; e < 8; ++e) o[e] = acc[ai][bj][m][e >> 2][e & 3] * sigmoidf_(x2[e]) * (MRG_F8 ? F8_SM * F8_WINV / F8_SL : 1.f);
#if MRG_F8
                u32x2 w; w.x = pack_fp8x4_sat(o[0], o[1], o[2], o[3]); w.y = pack_fp8x4_sat(o[4], o[5], o[6], o[7]);
                *(u32x2*)((unsigned char*)Mb + (size_t)row * D + col) = w;
#else
                u32x4 w; w.x = cvt_pk_bf16(o[0], o[1]); w.y = cvt_pk_bf16(o[2], o[3]); w.z = cvt_pk_bf16(o[4], o[5]); w.w = cvt_pk_bf16(o[6], o[7]);
                *(u32x4*)(Mb + (size_t)row * D + col) = w;
#endif
            }
        }
#undef EM_LOAD
    }
};
struct EpiX {
    static constexpr bool PERM = false, DUAL = false;
    const float* xlat; const float* xctx; const float* mod_g;
    bf16_t* X; int prev;
    __device__ __forceinline__ void operator()(AccT& acc, const Unit& u, int wr, int wc, int fr, int fq) const {
        const int bidx = u.pm < 32 ? 0 : (u.pm < 64 ? 1 : 2);
        const int rowb = u.pm * 256 + wr * 64 + fr, colb = u.pn * 256 + wc * 32 + 4 * fq;
        const float* g = mod_g + (size_t)bidx * 6144 + colb;
        const float* xi = ((u.pm < 64) ? xlat + (size_t)rowb * D : xctx + (size_t)(rowb - TLAT) * D) + colb;
        bf16_t* xo = X + (size_t)rowb * D + colb;
        f32x4 gg[4], xr[2][4];
#pragma unroll
        for (int q = 0; q < 4; ++q) gg[q] = *(const f32x4*)(g + (q >> 1) * 128 + (q & 1) * 16);
#define EX_LOAD(it_) do { _Pragma("unroll") for (int q = 0; q < 4; ++q) { const size_t o_ = (size_t)(((it_) >> 2) * 128 + ((it_) & 3) * 16) * D + (q >> 1) * 128 + (q & 1) * 16; \
            if (prev) xr[(it_) & 1][q] = bf4_to_f32x4(*(const u32x2*)(xo + o_)); else xr[(it_) & 1][q] = *(const f32x4*)(xi + o_); } } while (0)
        EX_LOAD(0);
#pragma unroll
        for (int it = 0; it < 8; ++it) {
            const int ai = it >> 2, m = it & 3;
            if (it + 1 < 8) EX_LOAD(it + 1);
#pragma unroll
            for (int q = 0; q < 4; ++q) { const f32x4 v = xr[it & 1][q] + gg[q] * (acc[ai][q >> 1][m][q & 1] * (MRG_F8 ? F8_WINV / F8_SM : 1.f));
                u32x2 w; w.x = cvt_pk_bf16(v[0], v[1]); w.y = cvt_pk_bf16(v[2], v[3]);
                *(u32x2*)(xo + (size_t)(ai * 128 + m * 16) * D + (q >> 1) * 128 + (q & 1) * 16) = w; }
        }
#undef EX_LOAD
    }
};
struct EpiACT {
    static constexpr bool PERM = true, DUAL = false;
    unsigned char* ACT; const float* bg; const float* bu;
    __device__ __forceinline__ void operator()(AccT& acc, const Unit& u, int wr, int wc, int fr, int fq) const {
        const int e = u.pn >> 3, pnl = u.pn & 7, col = pnl * 128 + wc * 32 + 8 * fq;
        const f32x4 g0 = *(const f32x4*)(bg + e * 1024 + col), g1 = *(const f32x4*)(bg + e * 1024 + col + 4), u0 = *(const f32x4*)(bu + e * 1024 + col), u1 = *(const f32x4*)(bu + e * 1024 + col + 4);
#pragma unroll
        for (int ai = 0; ai < 2; ++ai)
#pragma unroll
            for (int m = 0; m < 4; ++m) {
                const int row = u.pm * 256 + ai * 128 + wr * 64 + m * 16 + fr;
                float o[8];
#pragma unroll
                for (int k = 0; k < 8; ++k) {
                    float gv = acc[ai][0][m][k >> 2][k & 3] * F8_WINV + ((k < 4) ? g0[k & 3] : g1[k & 3]);
                    float uv = acc[ai][1][m][k >> 2][k & 3] * F8_WINV + ((k < 4) ? u0[k & 3] : u1[k & 3]);
                    gv = fminf(gv, 7.f); uv = __builtin_amdgcn_fmed3f(uv, -7.f, 7.f);
                    const float t = gv * __builtin_amdgcn_rcpf(1.f + __builtin_amdgcn_exp2f(gv * (-1.702f * LOG2E)));
                    o[k] = fmaf(t, uv, t);
                }
#if MOE2_F8
                u32x2 w; w.x = pack_fp8x4(o[0], o[1], o[2], o[3]); w.y = pack_fp8x4(o[4], o[5], o[6], o[7]);
                *(u32x2*)(ACT + (size_t)row * D + col) = w;
#else
                u32x4 w; w.x = cvt_pk_bf16(o[0], o[1]); w.y = cvt_pk_bf16(o[2], o[3]); w.z = cvt_pk_bf16(o[4], o[5]); w.w = cvt_pk_bf16(o[6], o[7]);
                *(u32x4*)((bf16_t*)ACT + (size_t)row * D + col) = w;
#endif
            }
    }
};
struct EpiY {
    static constexpr bool PERM = true, DUAL = false;
    bf16_t* Y; const float* bd; const u32x2* list;
    __device__ __forceinline__ void operator()(AccT& acc, const Unit& u, int wr, int wc, int fr, int fq) const {
        const int e = u.pn >> 2, pnl = u.pn & 3;
        const float* lw = (const float*)(list + (size_t)u.e * LCAP + u.rl * 256) + 1;
        bf16_t* yb = Y + (size_t)u.pm * 256 * D + pnl * 256;
        const float* bdp = bd + e * 1024 + pnl * 256;
        const unsigned lrow = (unsigned)opq_v(wr * 64 + fr), lcol = (unsigned)opq_v(wc * 32 + 8 * fq);
        float gwv[8]; f32x4 bv[2][2];
#pragma unroll
        for (int i = 0; i < 8; ++i) gwv[i] = lw[2 * (lrow + (i >> 2) * 128 + (i & 3) * 16)] * (MOE2_F8 ? F8_WINV : 1.f) * (Y_F8 ? 8.f : 1.f);
#pragma unroll
        for (int bj = 0; bj < 2; ++bj) { bv[bj][0] = *(const f32x4*)(bdp + lcol + bj * 128) * (MOE2_F8 ? 1.f / F8_WINV : 1.f); bv[bj][1] = *(const f32x4*)(bdp + lcol + bj * 128 + 4) * (MOE2_F8 ? 1.f / F8_WINV : 1.f); }
#pragma unroll
        for (int ai = 0; ai < 2; ++ai)
#pragma unroll
            for (int m = 0; m < 4; ++m) {
                const unsigned r = lrow + ai * 128 + m * 16;
                const float gw = gwv[ai * 4 + m];
#pragma unroll
                for (int bj = 0; bj < 2; ++bj) {
                    const unsigned c = lcol + bj * 128;
                    const f32x4 v0 = (acc[ai][bj][m][0] + bv[bj][0]) * gw, v1 = (acc[ai][bj][m][1] + bv[bj][1]) * gw;
#if Y_F8
                    { u32x2 w8; w8.x = pack_fp8x4_sat(v0[0], v0[1], v0[2], v0[3]); w8.y = pack_fp8x4_sat(v1[0], v1[1], v1[2], v1[3]);
                      *(u32x2*)((unsigned char*)Y + (size_t)u.pm * 256 * D + pnl * 256 + r * D + c) = w8; }
#else
                    u32x4 w; w.x = cvt_pk_bf16(v0[0], v0[1]); w.y = cvt_pk_bf16(v0[2], v0[3]); w.z = cvt_pk_bf16(v1[0], v1[1]); w.w = cvt_pk_bf16(v1[2], v1[3]);
                    *(u32x4*)(yb + r * D + c) = w;
#endif
                }
            }
    }
};

namespace att {
constexpr float SCALE = 0.07216878364870322f;
constexpr float THR = 2.6f;
constexpr int VPITCH = 80, SHM_V = 128 * VPITCH, KPITCH = 208, SHM_K = 64 * KPITCH, NBUF = 3, SHM_ATTN = NBUF * SHM_V + NBUF * SHM_K + 8 * 64 * 4;
#define KSWZ(row, chunk) ((row) * 384 + ((((chunk) ^ (((row) >> 1) & 7))) << 4))
#define SBAR() __builtin_amdgcn_sched_barrier(0)
__device__ __forceinline__ int crow(int r, int hi) { return (r & 3) + 8 * (r >> 2) + 4 * hi; }
__device__ __forceinline__ void partialSM(f32x16& p0, f32x16& p1, float& m_reg, float& mn, float& alpha) {
    constexpr float C = SCALE * 1.4426950408889634f;
    float pmax = p0[0];
#pragma unroll
    for (int r = 1; r < 16; ++r) pmax = fmaxf(pmax, p0[r]);
#pragma unroll
    for (int r = 0; r < 16; ++r) pmax = fmaxf(pmax, p1[r]);
    { auto rr = __builtin_amdgcn_permlane32_swap(__float_as_uint(pmax), __float_as_uint(pmax), false, false);
      pmax = fmaxf(__uint_as_float(rr[0]), __uint_as_float(rr[1])); }
    if (__builtin_expect(__all(pmax - m_reg <= THR / SCALE), 1)) { mn = m_reg; alpha = 1.f; }
    else { mn = fmaxf(m_reg, pmax); alpha = __builtin_amdgcn_exp2f((m_reg - mn) * C); m_reg = mn; }
    const float mnC = -mn * C + 5.f;
#pragma unroll
    for (int r = 0; r < 16; ++r) p0[r] = fmaf(p0[r], C, mnC);
#pragma unroll
    for (int r = 0; r < 16; ++r) p1[r] = fmaf(p1[r], C, mnC);
#pragma unroll
    for (int r = 0; r < 16; ++r) p0[r] = __builtin_amdgcn_exp2f(p0[r]);
}
__device__ __forceinline__ void finishSM(f32x16& p0, f32x16& p1, float alpha, float& l_reg, v8i& pa) {
#pragma unroll
    for (int r = 0; r < 16; ++r) p1[r] = __builtin_amdgcn_exp2f(p1[r]);
    float ps = 0;
#pragma unroll
    for (int r = 0; r < 16; ++r) ps += p0[r];
#pragma unroll
    for (int r = 0; r < 16; ++r) ps += p1[r];
    { auto rr = __builtin_amdgcn_permlane32_swap(__float_as_uint(ps), __float_as_uint(ps), false, false);
      ps = __uint_as_float(rr[0]) + __uint_as_float(rr[1]); }
    l_reg = l_reg * alpha + ps;
#pragma unroll
    for (int q = 0; q < 4; ++q) { pa[q] = (int)pack_fp8x4(p0[4 * q], p0[4 * q + 1], p0[4 * q + 2], p0[4 * q + 3]); pa[4 + q] = (int)pack_fp8x4(p1[4 * q], p1[4 * q + 1], p1[4 * q + 2], p1[4 * q + 3]); }
}
__device__ __forceinline__ void qkt(f32x16& p0, f32x16& p1, const char* Ks, const v8i* qr, int r32, int hi) {
    p0 = f32x16{}; p1 = f32x16{};
#pragma unroll
    for (int s = 0; s < 3; ++s) { const char* kp0 = Ks + r32 * KPITCH + s * 64 + hi * 32; const char* kp1 = kp0 + 32 * KPITCH;
        const v8i b0 = pg8::cat8(*reinterpret_cast<const bf16x8*>(kp0), *reinterpret_cast<const bf16x8*>(kp0 + 16));
        const v8i b1 = pg8::cat8(*reinterpret_cast<const bf16x8*>(kp1), *reinterpret_cast<const bf16x8*>(kp1 + 16));
        p0 = __builtin_amdgcn_mfma_scale_f32_32x32x64_f8f6f4(b0, qr[s], p0, 0, 0, 0, 127, 0, 127);
        p1 = __builtin_amdgcn_mfma_scale_f32_32x32x64_f8f6f4(b1, qr[s], p1, 0, 0, 0, 127, 0, 127); }
}
__device__ __forceinline__ void pv_d0(f32x16* o, const char* Vs, const v8i& pa, int r32, int hi) {
    v8i vf[4];
#pragma unroll
    for (int d0 = 0; d0 < 4; ++d0) { const char* vp = Vs + (d0 * 32 + r32) * VPITCH + hi * 32;
        vf[d0] = pg8::cat8(*reinterpret_cast<const bf16x8*>(vp), *reinterpret_cast<const bf16x8*>(vp + 16)); }
#pragma unroll
    for (int d0 = 0; d0 < 4; ++d0) o[d0] = __builtin_amdgcn_mfma_scale_f32_32x32x64_f8f6f4(pa, vf[d0], o[d0], 0, 0, 0, 127, 0, 127);
}
template <class Tick>
__device__ __forceinline__ void attn_unit(const unsigned char* __restrict__ Qb, const unsigned char* __restrict__ K8h, const unsigned char* __restrict__ Vt, const unsigned char* __restrict__ KPE, int krow_ctx, int krow_lat, int NT, int rot,
                                          bf16_t* __restrict__ Ob, char* lds, Tick& tick) {
    const int tid = opq_v(threadIdx.x), wid = tid >> 6, lane = tid & 63, r32 = lane & 31, hi = lane >> 5;
    char* V_lds = lds; char* K_lds = lds + NBUF * SHM_V;
    float* ws = (float*)(lds + NBUF * SHM_V + NBUF * SHM_K) + wid * 64; float* li_l = ws; float* al_l = ws + 32;
    float l_reg = 0; f32x16 o[4] = {}; v8i qr[3];
    const unsigned char* Qw = Qb + (size_t)(wid * 32 + r32) * NQ + hi * 32;
#pragma unroll
    for (int s3 = 0; s3 < 3; ++s3) qr[s3] = pg8::cat8(*reinterpret_cast<const bf16x8*>(Qw + s3 * 64), *reinterpret_cast<const bf16x8*>(Qw + s3 * 64 + 16));
    const unsigned voV = opq_v((tid >> 2) * KTOT + (tid & 3) * 16), voK = opq_v((tid >> 3) * 1024 + (tid & 7) * 16), voP = opq_v(((tid >> 2) & 63) * 64 + (tid & 3) * 16);
    const int lV = opq_v((tid >> 2) * VPITCH + (tid & 3) * 16), lK = opq_v((tid >> 3) * KPITCH + (tid & 7) * 16), lP = opq_v(((tid >> 2) & 63) * KPITCH + 128 + (tid & 3) * 16);
    bf16x8 vs0, ks0, kp; const bool wlo = __builtin_amdgcn_readfirstlane(tid >> 6) < 4;
#define KROW(j) (((j) < 4) ? (krow_ctx + 64 * (j)) : (krow_lat + 64 * ((j) - 4)))
#define SLOAD(j0_) do { int j_ = (j0_) + rot; j_ = j_ >= NT ? j_ - NT : j_;     \
    const int kr_ = KROW(j_); const unsigned char* vb_ = Vt + j_ * 64; const unsigned char* kb_ = K8h + (size_t)kr_ * 1024; const unsigned char* pb_ = KPE + (size_t)kr_ * 64; \
    vs0 = *reinterpret_cast<const bf16x8*>(vb_ + voV); ks0 = *reinterpret_cast<const bf16x8*>(kb_ + voK); \
    if (wlo) kp = *reinterpret_cast<const bf16x8*>(pb_ + voP); } while (0)
#define SWRITE(b) do { *(bf16x8*)(V_lds + (b) * SHM_V + lV) = vs0; *(bf16x8*)(K_lds + (b) * SHM_K + lK) = ks0; \
    if (wlo) *(bf16x8*)(K_lds + (b) * SHM_K + lP) = kp; } while (0)
#define SWAIT() asm volatile("s_waitcnt vmcnt(0)" ::: "memory")
#define RESC(a) do { if (__any((a) < 1.f)) { if (hi == 0) al_l[r32] = (a); asm volatile("s_waitcnt lgkmcnt(0)" ::: "memory"); \
    _Pragma("unroll") for (int d = 0; d < 4; ++d) _Pragma("unroll") for (int r = 0; r < 16; ++r) o[d][r] *= al_l[crow(r, hi)]; } } while (0)
#define LD32(p_) pg8::cat8(*reinterpret_cast<const bf16x8*>(p_), *reinterpret_cast<const bf16x8*>((p_) + 16))
#define MF(a_, b_, c_) __builtin_amdgcn_mfma_scale_f32_32x32x64_f8f6f4(a_, b_, c_, 0, 0, 0, 127, 0, 127)
#define MFQ(a_, b_, c_) __builtin_amdgcn_mfma_scale_f32_32x32x64_f8f6f4(a_, b_, c_, 0, 0, 0, 127, 0, 124)
#define EX4(P, i_) do { P[i_] = __builtin_amdgcn_exp2f(P[i_]); P[(i_) + 1] = __builtin_amdgcn_exp2f(P[(i_) + 1]); P[(i_) + 2] = __builtin_amdgcn_exp2f(P[(i_) + 2]); P[(i_) + 3] = __builtin_amdgcn_exp2f(P[(i_) + 3]); } while (0)
#define ROWMAX(pm_, P0, P1) do { float pm0_ = fmaxf(fmaxf(P0[0], P0[1]), P0[2]), pm1_ = fmaxf(fmaxf(P1[0], P1[1]), P1[2]); \
      _Pragma("unroll") for (int r = 3; r < 15; r += 2) { pm0_ = fmaxf(fmaxf(pm0_, P0[r]), P0[r + 1]); pm1_ = fmaxf(fmaxf(pm1_, P1[r]), P1[r + 1]); } \
      pm_ = fmaxf(fmaxf(pm0_, P0[15]), fmaxf(pm1_, P1[15])); } while (0)
#define XMAX(pm_) do { auto rr_ = __builtin_amdgcn_permlane32_swap(__float_as_uint(pm_), __float_as_uint(pm_), false, false); pm_ = fmaxf(__uint_as_float(rr_[0]), __uint_as_float(rr_[1])); } while (0)
#define VADD(d_, a_, b_) asm("v_add_f32 %0, %1, %2" : "=v"(d_) : "v"(a_), "v"(b_))
#define TAIL0() do { float sb; VADD(sa, pc0[0], pc0[1]); VADD(sb, pc0[2], pc0[3]); \
      _Pragma("unroll") for (int r = 4; r < 16; r += 2) { VADD(sa, sa, pc0[r]); VADD(sb, sb, pc0[r + 1]); } \
      VADD(sa, sa, sb); \
      _Pragma("unroll") for (int q = 0; q < 4; ++q)       \
          pa[q] = __builtin_amdgcn_cvt_pk_fp8_f32(pc0[4 * q + 2], pc0[4 * q + 3], __builtin_amdgcn_cvt_pk_fp8_f32(pc0[4 * q], pc0[4 * q + 1], pa[q], false), true); } while (0)
#define TAIL1() do { float sc, sd; VADD(sc, pc1[0], pc1[1]); VADD(sd, pc1[2], pc1[3]); \
      _Pragma("unroll") for (int r = 4; r < 16; r += 2) { VADD(sc, sc, pc1[r]); VADD(sd, sd, pc1[r + 1]); } \
      VADD(sc, sc, sd); \
      _Pragma("unroll") for (int q = 0; q < 4; ++q) \
          pa[4 + q] = __builtin_amdgcn_cvt_pk_fp8_f32(pc1[4 * q + 2], pc1[4 * q + 3], __builtin_amdgcn_cvt_pk_fp8_f32(pc1[4 * q], pc1[4 * q + 1], pa[4 + q], false), true); \
      { float ps = sa + sc; auto rr = __builtin_amdgcn_permlane32_swap(__float_as_uint(ps), __float_as_uint(ps), false, false); l_reg += __uint_as_float(rr[0]) + __uint_as_float(rr[1]); } } while (0)
#define STEP(s_) do { \
    if ((s_) + 1 < NT) { SWAIT(); SWRITE(bn); if ((s_) + 2 < NT) SLOAD((s_) + 2); } \
    { const char* Kc = K_lds + bc * SHM_K + r32 * KPITCH + hi * 32; const char* Vc = V_lds + bp * SHM_V + r32 * VPITCH + hi * 32; \
      v8i ka = LD32(Kc), kb = LD32(Kc + 32 * KPITCH), kc = LD32(Kc + 64), kd = LD32(Kc + 64 + 32 * KPITCH); \
      float sa; \
      SBAR(); TAIL0(); SBAR(); \
      pc0 = MFQ(ka, qr[0], bz); SBAR(); \
      TAIL1(); SBAR(); \
      pc1 = MFQ(kb, qr[0], bz); SBAR(); \
      ka = LD32(Kc + 128); kb = LD32(Kc + 128 + 32 * KPITCH); \
      SBAR(); pc0 = MFQ(kc, qr[1], pc0); pc1 = MFQ(kd, qr[1], pc1); SBAR(); \
      const v8i vf0 = LD32(Vc), vf1 = LD32(Vc + 32 * VPITCH), vf2 = LD32(Vc + 64 * VPITCH), vf3 = LD32(Vc + 96 * VPITCH); \
      SBAR(); pc0 = MFQ(ka, qr[2], pc0); pc1 = MFQ(kb, qr[2], pc1); SBAR(); \
      o[0] = MF(pa, vf0, o[0]); SBAR(); \
      float pm; ROWMAX(pm, pc0, pc1); \
      SBAR(); o[1] = MF(pa, vf1, o[1]); SBAR(); \
      asm volatile("" : "+v"(o[0]), "+v"(o[1]));     \
      XMAX(pm); \
      float al_ = 1.f; \
      if (__builtin_expect(__any(pm > LIM), 0)) {          \
          const float dl = fmaxf(pm - 5.f, 0.f); \
          _Pragma("unroll") for (int r = 0; r < 16; ++r) { pc0[r] -= dl; pc1[r] -= dl; } \
          { const float nb_ = bz[0] - dl; _Pragma("unroll") for (int r = 0; r < 16; ++r) bz[r] = nb_; } \
          al_ = __builtin_amdgcn_exp2f(-dl); l_reg *= al_; \
      } \
      SBAR(); o[2] = MF(pa, vf2, o[2]); SBAR(); \
      EX4(pc0, 0); EX4(pc0, 4); EX4(pc0, 8); EX4(pc0, 12); \
      SBAR(); o[3] = MF(pa, vf3, o[3]); SBAR(); \
      EX4(pc1, 0); EX4(pc1, 4); EX4(pc1, 8); EX4(pc1, 12); \
      asm volatile("" : "+v"(pc0), "+v"(pc1));     \
      RESC(al_); \
    } \
    __syncthreads(); \
    { const int t_ = bp; bp = bc; bc = bn; bn = t_; } } while (0)
    if (wid >= 4) __builtin_amdgcn_s_setprio(1);
    f32x16 pc0, pc1; v8i pa = {};
    constexpr float LIM = 5.f + THR * 1.4426950408889634f;
    f32x16 bz = {};
    int bp = 0, bc = 1, bn = 2;
    __syncthreads();
    {
        SLOAD(0); const bf16x8 va_ = vs0, ka_ = ks0, pa_ = kp; SLOAD(1); SWAIT();
        *(bf16x8*)(V_lds + lV) = va_; *(bf16x8*)(K_lds + lK) = ka_; if (wlo) *(bf16x8*)(K_lds + lP) = pa_;
        SWRITE(1); if (2 < NT) SLOAD(2); }
    __syncthreads();
    {
        const char* Kc = K_lds + r32 * KPITCH + hi * 32;
        pc0 = f32x16{}; pc1 = f32x16{};
#pragma unroll
        for (int s3 = 0; s3 < 3; ++s3) { const v8i ka = LD32(Kc + 64 * s3), kb = LD32(Kc + 64 * s3 + 32 * KPITCH); pc0 = MFQ(ka, qr[s3], pc0); pc1 = MFQ(kb, qr[s3], pc1); }
        float pm; ROWMAX(pm, pc0, pc1); XMAX(pm);
        const float dl = pm - 5.f;
#pragma unroll
        for (int r = 0; r < 16; ++r) { pc0[r] -= dl; pc1[r] -= dl; }
#pragma unroll
        for (int r = 0; r < 16; ++r) bz[r] = -dl;
        EX4(pc0, 0); EX4(pc0, 4); EX4(pc0, 8); EX4(pc0, 12); EX4(pc1, 0); EX4(pc1, 4); EX4(pc1, 8); EX4(pc1, 12);
    }
    for (int s = 1; s + 1 < NT; s += 2) {
        STEP(s);
        STEP(s + 1);
    }
    STEP(NT - 1);
    { float sa; TAIL0(); TAIL1(); }
    SBAR();
    pv_d0(o, V_lds + bp * SHM_V, pa, r32, hi);
    __builtin_amdgcn_s_setprio(0);
    if (hi == 0) li_l[r32] = l_reg; asm volatile("s_waitcnt lgkmcnt(0)" ::: "memory");
    float rli[16];
#pragma unroll
    for (int r = 0; r < 16; ++r) rli[r] = __builtin_amdgcn_rcpf(li_l[crow(r, hi)]);
    bf16_t* Ow = Ob + (size_t)(wid * 32) * 2048;
#pragma unroll
    for (int r = 0; r < 16; ++r) { const int orow = crow(r, hi);
#pragma unroll
        for (int d0 = 0; d0 < 4; ++d0) {
#if MRG_F8
            ((unsigned char*)Ob)[(size_t)(wid * 32 + orow) * 2048 + d0 * 32 + r32] = (unsigned char)(pack_fp8x4_sat(o[d0][r] * rli[r] * F8_SA, 0.f, 0.f, 0.f) & 0xffu);
#else
            Ow[(size_t)orow * 2048 + d0 * 32 + r32] = (bf16_t)(cvt_pk_bf16(o[d0][r] * rli[r], 0.f) & 0xffffu);
#endif
        } }
#undef STEP
#undef TAIL0
#undef TAIL1
#undef VADD
#undef LD32
#undef MF
#undef MFQ
#undef EX4
#undef ROWMAX
#undef XMAX
#undef KROW
#undef SLOAD
#undef SWRITE
#undef SWAIT
#undef RESC
}
}

struct Args { const float* in[33]; float* out; unsigned char* ws; int ph_lo, ph_hi; };
struct Ctx {
    unsigned char* lds; unsigned char* ws; int tid, lane, wave, G;
    InArr in;
};
__device__ __forceinline__ Ctx fresh(const Ctx& C0) {
    Ctx C; C.lds = C0.lds; C.ws = opq(C0.ws); C.in = opq_in(C0.in); C.G = C0.G; C.tid = opq_v(threadIdx.x); C.lane = C.tid & 63; C.wave = __builtin_amdgcn_readfirstlane(C.tid >> 6); return C;
}
enum { I_X = 0, I_C, I_CTX, I_CCTX, I_WADA, I_BADA, I_NMIX, I_NFFN, I_WIN, I_BBG, I_QN, I_WUQ, I_KVN, I_WUKV, I_WOA, I_CONVW, I_CONVB, I_LWA, I_LBA, I_LWX, I_LBX, I_LAM, I_WOL, I_WOUT, I_WR, I_BR,
       I_WEG, I_BEG, I_WEU, I_BEU, I_WED, I_BED, I_FN };

__device__ __forceinline__ void phase_adaln(const Ctx& C0, const Args& a) {
    const Ctx C = fresh(C0); unsigned char* ws = C.ws; InArr in = C.in; (void)ws; (void)in;
    LAS float* SC = (LAS float*)(C.lds);
    LAS float* RED = (LAS float*)(C.lds + 16384);
    float* MOD = (float*)(ws + WS_MOD);
    const int b = blockIdx.x;
    if (b < 192) {
        for (int i = C.tid; i < 3072; i += 512) { const int r = i >> 10, k = i & 1023; const float v = r < 2 ? inp(in, I_C)[r * 1024 + k] : inp(in, I_CCTX)[k]; SC[i] = v * sigmoidf_(v); }
        __syncthreads();
        for (int item = b; item < 192; item += C.G) {
            const int l = item / 96, cg = item % 96, col = cg * 64 + C.lane;
            const float* W = inp(in, I_WADA) + (size_t)l * 1024 * 6144 + col;
            float a0 = 0.f, a1 = 0.f, a2 = 0.f; const int k0 = C.wave * 128;
#pragma unroll 1
            for (int kb = 0; kb < 128; kb += 64) { float w[64];
#pragma unroll
                for (int i = 0; i < 64; ++i) w[i] = __builtin_nontemporal_load(W + (size_t)(k0 + kb + i) * 6144);
#pragma unroll
                for (int i = 0; i < 64; ++i) { a0 += SC[k0 + kb + i] * w[i]; a1 += SC[1024 + k0 + kb + i] * w[i]; a2 += SC[2048 + k0 + kb + i] * w[i]; } }
            RED[(C.wave * 3 + 0) * 64 + C.lane] = a0; RED[(C.wave * 3 + 1) * 64 + C.lane] = a1; RED[(C.wave * 3 + 2) * 64 + C.lane] = a2;
            __syncthreads();
            if (C.wave == 0) {
#pragma unroll
                for (int r = 0; r < 3; ++r) { float s = 0.f;
#pragma unroll
                    for (int w = 0; w < 8; ++w) s += RED[(w * 3 + r) * 64 + C.lane];
                    MOD[(size_t)(l * 3 + r) * 6144 + col] = s + inp(in, I_BADA)[l * 6144 + col]; }
            }
            __syncthreads();
        }
    }
    if (b == C.G - 1) {
        float* TAB = (float*)(ws + WS_TAB); float* LC = (float*)(ws + WS_LRUC);
        for (int i = C.tid; i < 2048; i += 512) { const int pos = i >> 4, j = i & 15;
            const float inv = __builtin_amdgcn_exp2f(-(float)j * (13.287712379549449f / 16.f));
            const float ang = (float)pos * inv; TAB[2 * i] = __cosf(ang); TAB[2 * i + 1] = __sinf(ang); }
        for (int i = C.tid; i < 4096; i += 512) { const float y = -inp(in, I_LAM)[i]; LC[i] = 8.f * (fmaxf(y, 0.f) + log1pf(expf(-fabsf(y)))); }
    }
}

__device__ __forceinline__ void build_mod_tables(const Ctx& C0, const Args& a, int l, int which, LAS float* GS, LAS float* SH) {
    const Ctx C = fresh(C0); unsigned char* ws = C.ws; InArr in = C.in; (void)ws; (void)in;
    const float* MOD = (const float*)(ws + WS_MOD); const float* gain = inp(in, which ? I_NFFN : I_NMIX) + l * 1024;
    for (int i = C.tid; i < 3072; i += 512) { const int r = i >> 10, k = i & 1023; const float* m = MOD + (size_t)(l * 3 + r) * 6144 + (which ? 3072 : 0);
        GS[i] = gain[k] * (1.f + m[1024 + k]); SH[i] = m[k]; }
}
__device__ __forceinline__ void norm_store_bf16(const f32x4 (&v)[4], const LAS float* gs, const LAS float* sh, bf16_t* orow, int lane) {
    float s = 0.f;
#pragma unroll
    for (int j = 0; j < 4; ++j) s += (v[j][0] * v[j][0] + v[j][1] * v[j][1]) + (v[j][2] * v[j][2] + v[j][3] * v[j][3]);
    const float rstd = __builtin_amdgcn_rsqf(wave_sum(s) * (1.f / 1024.f) + EPS);
#pragma unroll
    for (int j = 0; j < 4; ++j) { const int c = 4 * lane + 256 * j; const f32x4 g = *(const LAS f32x4*)(gs + c), h = *(const LAS f32x4*)(sh + c);
        const f32x4 y = v[j] * rstd * g + h;
#if G1_F8
        *(unsigned*)((unsigned char*)orow + c) = pack_fp8x4_sat(y[0], y[1], y[2], y[3]);
#else
        u32x2 w; w.x = cvt_pk_bf16(y[0], y[1]); w.y = cvt_pk_bf16(y[2], y[3]); *(u32x2*)(orow + c) = w;
#endif
    }
}

struct CvtDesc { const float* src; int K, N, Ndst; bf16_t* dst; int ldd, mode; const float* gain; int kt, nt, f8; };
__device__ __forceinline__ void cvt_load(const CvtDesc& d, int tid, f32x4 (&R)[8]) {
    const int k0 = d.kt * 128, n0 = d.nt * 128;
#pragma unroll
    for (int i = 0; i < 8; ++i) { const int idx = tid + 512 * i, gk = k0 + (idx >> 5), gn = n0 + (idx & 31) * 4;
        R[i] = (f32x4){0.f, 0.f, 0.f, 0.f};
        if (gk < d.K && gn < d.N) { R[i] = __builtin_nontemporal_load((const f32x4*)(d.src + (size_t)gk * d.N + gn)); if (d.gain) R[i] = R[i] * d.gain[gk]; } }
}
__device__ __forceinline__ void cvt_to_lds(const CvtDesc& d, LAS bf16_t* Tl, int tid, const f32x4 (&R)[8]) {
    if (d.f8) { LAS unsigned char* T8 = (LAS unsigned char*)Tl;
#pragma unroll
        for (int i = 0; i < 8; ++i) { const int idx = tid + 512 * i, k = idx >> 5, n4 = (idx & 31) * 4;
            *(LAS unsigned*)(T8 + k * 132 + (n4 ^ (4 * (k >> 4)))) = pack_fp8x4(R[i][0] * F8_WSCALE, R[i][1] * F8_WSCALE, R[i][2] * F8_WSCALE, R[i][3] * F8_WSCALE); }
    } else {
#pragma unroll
        for (int i = 0; i < 8; ++i) { const int idx = tid + 512 * i, k = idx >> 5, n4 = (idx & 31) * 4;
            u32x2 w; w.x = cvt_pk_bf16(R[i][0], R[i][1]); w.y = cvt_pk_bf16(R[i][2], R[i][3]); *(LAS u32x2*)(Tl + k * 132 + n4) = w; }
    }
}
__device__ __forceinline__ void cvt_store(const CvtDesc& d, LAS bf16_t* Tl, int tid) {
    const int k0 = d.kt * 128, n0 = d.nt * 128;
    const int drow0 = d.mode == 0 ? n0 : ((n0 >> 7) * 256 + (d.mode - 1) * 128);
    if (d.f8) { const LAS unsigned char* T8 = (const LAS unsigned char*)Tl; unsigned char* dst8 = (unsigned char*)d.dst;
#pragma unroll
        for (int p = 0; p < 2; ++p) { const int q = tid + 512 * p, nl = q >> 3, k16 = (q & 7) * 16, nsw = nl ^ (4 * (q & 7));
            unsigned w[4], bb[16];
#pragma unroll
            for (int i = 0; i < 16; ++i) bb[i] = T8[(k16 + i) * 132 + nsw];
            __builtin_amdgcn_sched_barrier(0);
#pragma unroll
            for (int j = 0; j < 4; ++j) w[j] = bb[4 * j] | (bb[4 * j + 1] << 8) | (bb[4 * j + 2] << 16) | (bb[4 * j + 3] << 24);
            *(u32x4*)(dst8 + (size_t)(drow0 + nl) * d.ldd + k0 + k16) = (u32x4){w[0], w[1], w[2], w[3]}; }
        return; }
#pragma unroll
    for (int p = 0; p < 4; ++p) { const int nl = (tid & 31) + 32 * p, k8 = ((tid >> 5) & 15) * 8;
        if (n0 + nl < d.Ndst && k0 + k8 < d.K) {
            unsigned short e[8];
#pragma unroll
            for (int i = 0; i < 8; ++i) e[i] = Tl[(k8 + i) * 132 + nl];
            u32x4 w; w.x = e[0] | ((unsigned)e[1] << 16); w.y = e[2] | ((unsigned)e[3] << 16); w.z = e[4] | ((unsigned)e[5] << 16); w.w = e[6] | ((unsigned)e[7] << 16);
            *(u32x4*)(d.dst + (size_t)(drow0 + nl) * d.ldd + k0 + k8) = w; } }
}
constexpr int CV_WIN = 8 * 36, CV_WUQ = 2 * 12, CV_WUKV = 16, CV_SQ = 64, CV_WR = 8, CV_LW = 64, CV_EXP = 32 * 64;
constexpr int CV_SMALL = CV_WIN + CV_WUQ + CV_WUKV + 3 * CV_SQ + CV_WR + CV_LW;
constexpr int CV_LAYER = CV_SMALL + 3 * CV_EXP, CV_TOTAL = 2 * CV_LAYER;
__device__ __forceinline__ CvtDesc cvt_decode(unsigned char* ws, InArr in, int item) {
    const int l = item / CV_LAYER; int r = item % CV_LAYER;
    unsigned char* wl = ws + WS_WL + (size_t)l * WL_STRIDE;
    CvtDesc d; d.gain = nullptr; d.mode = 0; d.f8 = 0;
    if (r < CV_WIN) { d.src = inp(in, I_WIN) + (size_t)l * 1024 * DIN; d.K = 1024; d.N = DIN; d.Ndst = DINP; d.dst = (bf16_t*)(wl + OFF_WIN); d.ldd = 1024; d.f8 = G1_F8; d.kt = r / 36; d.nt = r % 36; return d; } r -= CV_WIN;
    if (r < CV_WUQ) { d.src = inp(in, I_WUQ) + (size_t)l * 256 * NQ; d.K = 256; d.N = NQ; d.Ndst = NQ; d.dst = (bf16_t*)(wl + OFF_WUQ); d.ldd = 256; d.gain = inp(in, I_QN) + l * 256; d.kt = r / 12; d.nt = r % 12; return d; } r -= CV_WUQ;
    if (r < CV_WUKV) { d.src = inp(in, I_WUKV) + (size_t)l * 128 * NKV; d.K = 128; d.N = NKV; d.Ndst = NKV; d.dst = (bf16_t*)(wl + OFF_WUKV); d.ldd = 128; d.gain = inp(in, I_KVN) + l * 128; d.kt = 0; d.nt = r; return d; } r -= CV_WUKV;
    if (r < CV_SQ) { d.src = inp(in, I_WOA) + (size_t)l * D * D; d.K = D; d.N = D; d.Ndst = D; d.dst = (bf16_t*)(wl + OFF_WM); d.ldd = 2048; d.f8 = MRG_F8; d.kt = r >> 3; d.nt = r & 7; return d; } r -= CV_SQ;
    if (r < CV_SQ) { d.src = inp(in, I_WOL) + (size_t)l * D * D; d.K = D; d.N = D; d.Ndst = D; d.dst = (bf16_t*)(wl + OFF_WM + (MRG_F8 ? 1024 : 2048)); d.ldd = 2048; d.f8 = MRG_F8; d.kt = r >> 3; d.nt = r & 7; return d; } r -= CV_SQ;
    if (r < CV_SQ) { d.src = inp(in, I_WOUT) + (size_t)l * D * D; d.K = D; d.N = D; d.Ndst = D; d.dst = (bf16_t*)(wl + OFF_WOUT); d.ldd = 1024; d.f8 = MRG_F8; d.kt = r >> 3; d.nt = r & 7; return d; } r -= CV_SQ;
    if (r < CV_WR) { d.src = inp(in, I_WR) + (size_t)l * D * NE; d.K = D; d.N = NE; d.Ndst = NE; d.dst = (bf16_t*)(wl + OFF_WR); d.ldd = 1024; d.kt = r; d.nt = 0; return d; } r -= CV_WR;
    if (r < CV_LW) { const int g = r & 1, dn = r >> 1, dd = dn >> 4, nb = dn & 15;
        d.src = inp(in, g ? I_LWX : I_LWA) + ((size_t)(l * 2 + dd) * 16 + nb) * 4096; d.K = 64; d.N = 64; d.Ndst = 64; d.dst = (bf16_t*)(wl + OFF_LW) + ((size_t)nb * 4 + 2 * dd + g) * 4096; d.ldd = 64; d.kt = 0; d.nt = 0; return d; } r -= CV_LW;
    const int which = r / CV_EXP; r %= CV_EXP; const int e = r >> 6, t = r & 63;
    d.K = D; d.N = D; d.Ndst = D; d.kt = t >> 3; d.nt = t & 7; d.ldd = 1024;
    d.f8 = 1;
    if (which == 0) { d.src = inp(in, I_WEG) + ((size_t)l * NE + e) * D * D; d.dst = (bf16_t*)(ws + WS_WGU + (size_t)l * WGU_STRIDE + (size_t)e * 2048 * 1024); d.mode = 1; }
    else if (which == 1) { d.src = inp(in, I_WEU) + ((size_t)l * NE + e) * D * D; d.dst = (bf16_t*)(ws + WS_WGU + (size_t)l * WGU_STRIDE + (size_t)e * 2048 * 1024); d.mode = 2; }
    else { d.src = inp(in, I_WED) + ((size_t)l * NE + e) * D * D; d.f8 = MOE2_F8; d.dst = (bf16_t*)(ws + WS_WD + (size_t)l * WD_STRIDE + (size_t)e * 1024 * 1024 * (MOE2_F8 ? 1 : 2)); }
    return d;
}
static_assert(MOE2_F8 == 1, "the engine writes e4m3 for all three expert matrices");
struct CvtEngine {
    unsigned char* ws; InArr in; LAS unsigned char* T8; int l, nxt, end, vR, vL; f32x4 R[4];
    unsigned char* dstR; unsigned char* dstL;
    __device__ __forceinline__ void issue() {
        vR = nxt < end;
        if (vR) {
            const int tid = opq_v(threadIdx.x);
            const int r = nxt >> 1, half = nxt & 1, which = r >> 11, rr = r & 2047, e = rr >> 6, t = rr & 63, kt = t >> 3, nt = t & 7, k0 = kt * 128 + half * 64;
            const float* src = inp(in, which == 0 ? I_WEG : which == 1 ? I_WEU : I_WED) + ((size_t)l * NE + e) * D * D + (size_t)k0 * 1024 + nt * 128;
            dstR = which < 2 ? ws + WS_WGU + (size_t)l * WGU_STRIDE + (size_t)e * 2048 * 1024 + (size_t)(nt * 256 + which * 128) * 1024 + k0
                             : ws + WS_WD + (size_t)l * WD_STRIDE + (size_t)e * 1024 * 1024 + (size_t)(nt * 128) * 1024 + k0;
            src = opq(src);
#pragma unroll
            for (int i = 0; i < 4; ++i) { const int idx = tid + 512 * i; R[i] = __builtin_nontemporal_load((const f32x4*)(src + (unsigned)((idx >> 5) * 1024 + (idx & 31) * 4))); }
            nxt += 256;
        }
    }
    __device__ __forceinline__ void A() {
        vL = vR; dstL = dstR;
        if (vR) {
            const int tid = opq_v(threadIdx.x);
#pragma unroll
            for (int i = 0; i < 4; ++i) { const int idx = tid + 512 * i, k = idx >> 5, n4 = (idx & 31) * 4;
                *(LAS unsigned*)(T8 + k * 132 + (n4 ^ (4 * (k >> 4)))) = pack_fp8x4(R[i][0] * F8_WSCALE, R[i][1] * F8_WSCALE, R[i][2] * F8_WSCALE, R[i][3] * F8_WSCALE); }
        }
        issue();
    }
    __device__ __forceinline__ void B() {
        if (vL) {
            const int q = opq_v(threadIdx.x), nl = q >> 2, k16 = (q & 3) * 16, nsw = nl ^ (4 * (q & 3));
            unsigned w[4], bb[16];
#pragma unroll
            for (int i = 0; i < 16; ++i) bb[i] = T8[(k16 + i) * 132 + nsw];
            __builtin_amdgcn_sched_barrier(0);
#pragma unroll
            for (int j = 0; j < 4; ++j) w[j] = bb[4 * j] | (bb[4 * j + 1] << 8) | (bb[4 * j + 2] << 16) | (bb[4 * j + 3] << 24);
            *(u32x4*)(dstL + (unsigned)(nl * 1024 + k16)) = (u32x4){w[0], w[1], w[2], w[3]};
        }
        vL = 0;
    }
};
struct NoTick { __device__ __forceinline__ void step() {} };
constexpr int ATT_CVT_OFF = 73728;
constexpr int ENG_H1 = 16, ENG_H2 = 32;
constexpr int ENG_ITEMS = 3 * CV_EXP;
__device__ __forceinline__ void phase_prologue(const Ctx& C0, const Args& a) {
    const Ctx C = fresh(C0); unsigned char* ws = C.ws; InArr in = C.in; (void)ws; (void)in;
    LAS float* GS = (LAS float*)(C.lds + 65536); LAS float* SH = GS + 3072;
    build_mod_tables(C, a, 0, 0, GS, SH);
    __syncthreads();
    bf16_t* H = (bf16_t*)(ws + WS_H);
    for (int row = blockIdx.x * 8 + C.wave; row < T; row += C.G * 8) {
        const float* xr = row < TLAT ? inp(in, I_X) + (size_t)row * D : inp(in, I_CTX) + (size_t)(row - TLAT) * D;
        const int r = row < TLAT ? (row >> 13) : 2;
        f32x4 v[4];
#pragma unroll
        for (int j = 0; j < 4; ++j) v[j] = *(const f32x4*)(xr + 4 * C.lane + 256 * j);
        norm_store_bf16(v, GS + r * 1024, SH + r * 1024, H + (size_t)row * (G1_F8 ? D / 2 : D), C.lane);
    }
    __syncthreads();
    {
        LAS bf16_t* Tl = (LAS bf16_t*)(C.lds);
        const int eng = (opq_i(C.G) == 256) ? ENG_ITEMS : 0, per = CV_LAYER - eng; const int NSM = 2 * per;
#define SMALL_ITEM(i_) (((i_) / per) * CV_LAYER + (((i_) % per) < CV_SMALL ? ((i_) % per) : ((i_) % per) + eng))
        int it = blockIdx.x; CvtDesc d, dn; f32x4 R[8];
        if (it < NSM) { d = cvt_decode(ws, in, SMALL_ITEM(it)); cvt_load(d, C.tid, R); }
#pragma unroll 1
        for (; it < NSM; it += C.G) {
            cvt_to_lds(d, Tl, C.tid, R);
            __syncthreads();
            const int nxt = it + C.G;
            if (nxt < NSM) { dn = cvt_decode(ws, in, SMALL_ITEM(nxt)); cvt_load(dn, C.tid, R); }
            cvt_store(d, Tl, C.tid);
            __syncthreads();
            d = dn;
        }
#undef SMALL_ITEM
    }
}
__device__ __forceinline__ void kpe_rope(const Ctx& C0) {
    const Ctx C = fresh(C0); unsigned char* ws = C.ws; InArr in = C.in; (void)ws; (void)in;
    const bf16_t* Z = (const bf16_t*)(ws + WS_Z); bf16_t* KPE = (bf16_t*)(ws + WS_KPE); const float* TAB = (const float*)(ws + WS_TAB);
    constexpr int NI = (T * 32 + 256 * 512 - 1) / (256 * 512);
    const int i0 = blockIdx.x * 512 + C.tid, st = C.G * 512;
    if (C.G == 256) {
        bf16_t z1[NI], z2[NI]; float cs[NI], sn[NI];
#pragma unroll
        for (int q = 0; q < NI; ++q) { const int i = i0 + q * st; z1[q] = 0; z2[q] = 0; cs[q] = 1.f; sn[q] = 0.f;
            if (i < T * 32) { const int row = i >> 5, p = i & 31, aa = p >> 4, j = p & 15;
                z1[q] = Z[(size_t)row * DINP + ZC_KPE + aa * 32 + j]; z2[q] = Z[(size_t)row * DINP + ZC_KPE + aa * 32 + 16 + j];
                if (row < TLAT) { const int npos = row & 8191, pos = aa == 0 ? (npos >> 6) : (npos & 63); cs[q] = TAB[(pos * 16 + j) * 2]; sn[q] = TAB[(pos * 16 + j) * 2 + 1]; } } }
#pragma unroll
        for (int q = 0; q < NI; ++q) { const int i = i0 + q * st;
            if (i < T * 32) { const int row = i >> 5, p = i & 31, aa = p >> 4, j = p & 15;
                float x1 = bf1(z1[q]), x2 = bf1(z2[q]);
                if (row < TLAT) { const float o1 = x1 * cs[q] - x2 * sn[q], o2 = x1 * sn[q] + x2 * cs[q]; x1 = o1; x2 = o2; }
                const unsigned pk = pack_fp8x4_sat(x1, x2, 0.f, 0.f);
                ((unsigned char*)KPE)[(size_t)row * 64 + aa * 32 + j] = (unsigned char)(pk & 0xffu); ((unsigned char*)KPE)[(size_t)row * 64 + aa * 32 + 16 + j] = (unsigned char)((pk >> 8) & 0xffu); } }
        return;
    }
    for (int i = i0; i < T * 32; i += st) {
        const int row = i >> 5, p = i & 31, aa = p >> 4, j = p & 15;
        float x1 = bf1(Z[(size_t)row * DINP + ZC_KPE + aa * 32 + j]), x2 = bf1(Z[(size_t)row * DINP + ZC_KPE + aa * 32 + 16 + j]);
        if (row < TLAT) { const int npos = row & 8191, pos = aa == 0 ? (npos >> 6) : (npos & 63); const float cs = TAB[(pos * 16 + j) * 2], sn = TAB[(pos * 16 + j) * 2 + 1];
            const float o1 = x1 * cs - x2 * sn, o2 = x1 * sn + x2 * cs; x1 = o1; x2 = o2; }
        const unsigned pk = pack_fp8x4_sat(x1, x2, 0.f, 0.f);
        ((unsigned char*)KPE)[(size_t)row * 64 + aa * 32 + j] = (unsigned char)(pk & 0xffu); ((unsigned char*)KPE)[(size_t)row * 64 + aa * 32 + 16 + j] = (unsigned char)((pk >> 8) & 0xffu);
    }
}

constexpr int LR_LW = 0, LR_XLB = 36864, LR_XLF = 46080, LR_AU = 63488, LR_SEG = 133120, LR_CAR = 137216, LR_CVT = 145920, LR_P = 68;
__device__ __forceinline__ void lru_load_weights(const Ctx& C0, int l, int nb) {
    const Ctx C = fresh(C0); unsigned char* ws = C.ws; InArr in = C.in; (void)ws; (void)in;
    const bf16_t* LW = (const bf16_t*)(ws + WS_WL + (size_t)l * WL_STRIDE + OFF_LW) + (size_t)nb * 4 * 4096;
    u32x4 w[4];
#pragma unroll
    for (int j = 0; j < 4; ++j) { const int i = C.tid + 512 * j, row = i >> 3, c8 = (i & 7) * 8; w[j] = *(const u32x4*)(LW + row * 64 + c8); }
#pragma unroll
    for (int j = 0; j < 4; ++j) { const int i = C.tid + 512 * j, row = i >> 3, c8 = (i & 7) * 8; *(LAS u32x4*)(C.lds + LR_LW + (row * 72 + c8) * 2) = w[j]; }
}
__device__ __forceinline__ int carry_chunk(int b, int dir, int p) {
    return dir == 0 ? (p < 4 ? 256 + 4 * b + p : 128 * b + (p - 4)) : (p < 4 ? 256 + 4 * b + 3 - p : 128 * b + 127 - (p - 4));
}
__device__ __forceinline__ void lru_load_x(const bf16_t* Z, int cidx, int nb, int tid, u32x4 (&xv)[4]) {
    const int row0 = cidx * 64, seq0 = row0 < TLAT ? (row0 & ~8191) : (row0 & ~255), seqL = row0 < TLAT ? SEQ : CTXL;
    const int t = tid >> 3, ch = nb * 64 + (tid & 7) * 8, n = row0 + t - seq0;
#pragma unroll
    for (int k = 0; k < 4; ++k) { const int nn = n + k - 2; xv[k] = (u32x4){0u, 0u, 0u, 0u};
        if (nn >= 0 && nn < seqL) xv[k] = *(const u32x4*)(Z + (size_t)(seq0 + nn) * DINP + ZC_XR + ch); }
}
template <int PASS>
__device__ __forceinline__ void lru_pass(const Ctx& C0, const Args& a, int l) {
    const Ctx C = fresh(C0); unsigned char* ws = C.ws; InArr in = C.in;
    const int nb = blockIdx.x & 15, cstep = C.G >> 4;
    CvtEngine E; E.ws = ws; E.in = in; E.T8 = (LAS unsigned char*)(C.lds + LR_CVT); E.l = l; E.vR = 0; E.vL = 0; E.dstR = ws; E.dstL = ws;
#pragma unroll
    for (int i = 0; i < 4; ++i) E.R[i] = (f32x4){0.f, 0.f, 0.f, 0.f};
    { const int b = __builtin_amdgcn_readfirstlane((int)blockIdx.x);
      E.nxt = b + 256 * (PASS == 1 ? 0 : ENG_H1); E.end = (opq_i(C.G) == 256) ? 256 * (PASS == 1 ? ENG_H1 : ENG_H1 + ENG_H2) : 0; }
    E.issue();
    const bf16_t* Z = (const bf16_t*)(ws + WS_Z);
    LAS bf16_t* XLB = (LAS bf16_t*)(C.lds + LR_XLB); LAS float* XLF = (LAS float*)(C.lds + LR_XLF); LAS float* AU = (LAS float*)(C.lds + LR_AU);
    LAS f32x2* SEG = (LAS f32x2*)(C.lds + LR_SEG);
    __syncthreads();
    lru_load_weights(C, l, nb);
    const int ct_t = C.tid >> 3, c8 = (C.tid & 7) * 8, fr = C.lane & 15, fq = C.lane >> 4;
    float cw[4][8], cb[8];
    { const float* cbp = inp(in, I_CONVB) + l * 1024 + nb * 64 + c8;
#pragma unroll
      for (int i = 0; i < 8; ++i) cb[i] = cbp[i];
#pragma unroll
      for (int k = 0; k < 4; ++k) { const float* w = inp(in, I_CONVW) + (size_t)(l * 4 + k) * 1024 + nb * 64 + c8;
#pragma unroll
          for (int i = 0; i < 8; ++i) cw[k][i] = w[i]; } }
    float gba[2][2], gbx[2][2], gcc[2][2];
    { const float* LC = (const float*)(ws + WS_LRUC) + (size_t)l * 2048;
#pragma unroll
      for (int s2 = 0; s2 < 2; ++s2) { const int ch = nb * 64 + ((C.wave * 2 + s2) & 3) * 16 + fr;
#pragma unroll
          for (int dd = 0; dd < 2; ++dd) { gba[s2][dd] = -LOG2E * inp(in, I_LBA)[(l * 2 + dd) * 1024 + ch]; gbx[s2][dd] = -LOG2E * inp(in, I_LBX)[(l * 2 + dd) * 1024 + ch]; gcc[s2][dd] = -LOG2E * LC[dd * 1024 + ch]; } } }
    const int dir = C.tid >> 8, seg = (C.tid >> 6) & 3, chl = C.tid & 63;
    LAS float* CARL = (LAS float*)(C.lds + LR_CAR);
    if (PASS == 2) {
        if (C.tid < 256) { const int cd = C.tid >> 7, cb = (C.tid >> 6) & 1, ch = nb * 64 + (C.tid & 63), c0 = blockIdx.x >> 4;
            const f32x2* SUM = (const f32x2*)(ws + WS_SUM); float S = 0.f;
#pragma unroll 1
            for (int p0 = 0; p0 < 132; p0 += 33) { f32x2 v[33];
#pragma unroll
                for (int i = 0; i < 33; ++i) v[i] = SUM[((size_t)carry_chunk(cb, cd, p0 + i) * 2 + cd) * 1024 + ch];
#pragma unroll
                for (int i = 0; i < 33; ++i) { const int c = carry_chunk(cb, cd, p0 + i); if ((c - c0) % cstep == 0) CARL[(((c - c0) / cstep) * 2 + cd) * 64 + (C.tid & 63)] = S; S = v[i][0] * S + v[i][1]; } } }
        __syncthreads();
    }
    LAS float* Aa = AU + (2 * dir) * 64 * LR_P; LAS float* Ua = AU + (2 * dir + 1) * 64 * LR_P;
    int cidx = blockIdx.x >> 4;
    u32x4 xn[4]; u32x4 grn = (u32x4){0u, 0u, 0u, 0u};
    if (cidx < NCHUNK) { lru_load_x(Z, cidx, nb, C.tid, xn);
        if (PASS == 2) { grn = *(const u32x4*)(Z + (size_t)(cidx * 64 + ct_t) * DINP + ZC_GR + nb * 64 + c8); } }
#pragma unroll 1
    for (; cidx < NCHUNK; cidx += cstep) {
        u32x4 xv[4]; const u32x4 gr = grn;
#pragma unroll
        for (int k = 0; k < 4; ++k) xv[k] = xn[k];
        {
            float acc[8];
#pragma unroll
            for (int i = 0; i < 8; ++i) acc[i] = cb[i];
#pragma unroll
            for (int k = 0; k < 4; ++k) { const u32x4 x = xv[k];
                acc[0] += bf_lo(x.x) * cw[k][0]; acc[1] += bf_hi(x.x) * cw[k][1]; acc[2] += bf_lo(x.y) * cw[k][2]; acc[3] += bf_hi(x.y) * cw[k][3];
                acc[4] += bf_lo(x.z) * cw[k][4]; acc[5] += bf_hi(x.z) * cw[k][5]; acc[6] += bf_lo(x.w) * cw[k][6]; acc[7] += bf_hi(x.w) * cw[k][7]; }
            u32x4 w; w.x = cvt_pk_bf16(acc[0], acc[1]); w.y = cvt_pk_bf16(acc[2], acc[3]); w.z = cvt_pk_bf16(acc[4], acc[5]); w.w = cvt_pk_bf16(acc[6], acc[7]);
            *(LAS u32x4*)(XLB + ct_t * 72 + c8) = w;
            *(LAS f32x4*)(XLF + ct_t * LR_P + c8) = (f32x4){acc[0], acc[1], acc[2], acc[3]}; *(LAS f32x4*)(XLF + ct_t * LR_P + c8 + 4) = (f32x4){acc[4], acc[5], acc[6], acc[7]};
        }
        __syncthreads(); E.A();
        { const int cnext = cidx + cstep;
          if (cnext < NCHUNK) { lru_load_x(Z, cnext, nb, C.tid, xn);
              if (PASS == 2) { grn = *(const u32x4*)(Z + (size_t)(cnext * 64 + ct_t) * DINP + ZC_GR + nb * 64 + c8); } } }
#pragma unroll
        for (int s2 = 0; s2 < 2; ++s2) {
            const int q = C.wave * 2 + s2, tt = q >> 2, ct = q & 3;
            f32x4 g[4];
#pragma unroll
            for (int gi = 0; gi < 4; ++gi) g[gi] = (f32x4){0.f, 0.f, 0.f, 0.f};
#pragma unroll
            for (int ks = 0; ks < 2; ++ks) {
                const bf16x8 av = *(const LAS bf16x8*)(XLB + (tt * 16 + fr) * 72 + ks * 32 + fq * 8);
#pragma unroll
                for (int gi = 0; gi < 4; ++gi) { const bf16x8 bv = *(const LAS bf16x8*)(C.lds + LR_LW + ((gi * 64 + ct * 16 + fr) * 72 + ks * 32 + fq * 8) * 2);
                    g[gi] = __builtin_amdgcn_mfma_f32_16x16x32_bf16(av, bv, g[gi], 0, 0, 0); }
            }
            const int chl2 = ct * 16 + fr;
#pragma unroll
            for (int dd = 0; dd < 2; ++dd) {
#pragma unroll
                for (int j = 0; j < 4; ++j) { const int t = tt * 16 + 4 * fq + j;
                    const float p1 = 1.f + __builtin_amdgcn_exp2f(fminf(__builtin_fmaf(g[2 * dd][j], -LOG2E, gba[s2][dd]), 40.f)), p2 = 1.f + __builtin_amdgcn_exp2f(fminf(__builtin_fmaf(g[2 * dd + 1][j], -LOG2E, gbx[s2][dd]), 40.f));
                    const float inv = __builtin_amdgcn_rcpf(p1 * p2), r = p2 * inv, ig = p1 * inv;
                    const float av = __builtin_amdgcn_exp2f(gcc[s2][dd] * r), uv = __builtin_amdgcn_sqrtf(fmaxf(__builtin_fmaf(-av, av, 1.f), 0.f)) * ig * XLF[t * LR_P + chl2];
                    AU[(2 * dd) * 64 * LR_P + t * LR_P + chl2] = av; AU[(2 * dd + 1) * 64 * LR_P + t * LR_P + chl2] = uv; }
            }
        }
        __syncthreads(); E.B();
        {
            float Ap = 1.f, Hh = 0.f;
#pragma unroll
            for (int s2 = 0; s2 < 16; ++s2) { const int t = seg * 16 + (dir ? 15 - s2 : s2); const float av = Aa[t * LR_P + chl]; Hh = av * Hh + Ua[t * LR_P + chl]; Ap *= av; }
            SEG[(dir * 4 + seg) * 64 + chl] = (f32x2){Ap, Hh};
        }
        __syncthreads(); if (PASS == 2) E.A();
        if (PASS == 1) {
            if (seg == 0) { float At = 1.f, Ht = 0.f;
#pragma unroll
                for (int s2 = 0; s2 < 4; ++s2) { const f32x2 v = SEG[(dir * 4 + (dir ? 3 - s2 : s2)) * 64 + chl]; Ht = v[0] * Ht + v[1]; At *= v[0]; }
                ((f32x2*)(ws + WS_SUM))[((size_t)cidx * 2 + dir) * 1024 + nb * 64 + chl] = (f32x2){At, Ht}; }
        } else {
            float S = CARL[(((cidx - (int)(blockIdx.x >> 4)) / cstep) * 2 + dir) * 64 + chl];
            const int npre = dir ? 3 - seg : seg;
            for (int s2 = 0; s2 < npre; ++s2) { const f32x2 v = SEG[(dir * 4 + (dir ? 3 - s2 : s2)) * 64 + chl]; S = v[0] * S + v[1]; }
            { float av[16], uv[16];
#pragma unroll
              for (int s2 = 0; s2 < 16; ++s2) { const int t = seg * 16 + (dir ? 15 - s2 : s2); av[s2] = Aa[t * LR_P + chl]; uv[s2] = Ua[t * LR_P + chl]; }
#pragma unroll
              for (int s2 = 0; s2 < 16; ++s2) { const int t = seg * 16 + (dir ? 15 - s2 : s2); S = av[s2] * S + uv[s2]; Ua[t * LR_P + chl] = S; } }
            __syncthreads(); E.B();
            const int row = cidx * 64 + ct_t;
            const float gv[8] = {bf_lo(gr.x), bf_hi(gr.x), bf_lo(gr.y), bf_hi(gr.y), bf_lo(gr.z), bf_hi(gr.z), bf_lo(gr.w), bf_hi(gr.w)};
            float o[8];
#pragma unroll
            for (int i = 0; i < 8; ++i) o[i] = (AU[1 * 64 * LR_P + ct_t * LR_P + c8 + i] + AU[3 * 64 * LR_P + ct_t * LR_P + c8 + i]) * gelu_tanh(gv[i]);
            u32x4 w; w.x = cvt_pk_bf16(o[0], o[1]); w.y = cvt_pk_bf16(o[2], o[3]); w.z = cvt_pk_bf16(o[4], o[5]); w.w = cvt_pk_bf16(o[6], o[7]);
#if MRG_F8
            { u32x2 w8; w8.x = pack_fp8x4_sat(o[0] * F8_SL, o[1] * F8_SL, o[2] * F8_SL, o[3] * F8_SL); w8.y = pack_fp8x4_sat(o[4] * F8_SL, o[5] * F8_SL, o[6] * F8_SL, o[7] * F8_SL);
              *(u32x2*)(ws + WS_AL + (size_t)row * 2048 + 1024 + nb * 64 + c8) = w8; }
#else
            *(u32x4*)((bf16_t*)(ws + WS_AL) + (size_t)row * 2048 + 1024 + nb * 64 + c8) = w;
#endif
        }
    }
    __syncthreads();
    while (E.vR) { E.A(); __syncthreads(); E.B(); __syncthreads(); }
}
constexpr int P7_WRT = 0, P7_H2T = 66048, P7_RED = 99072, P7_GS = 115456, P7_LC = 140032, P7_BASE = 140160, P7_ENT = 140288, P7_PITCH = 1032;
__device__ __forceinline__ void phase_router(const Ctx& C0, const Args& a, int l, int Tm) {
    const Ctx C = fresh(C0); unsigned char* ws = C.ws; InArr in = C.in; (void)ws; (void)in;
    LAS bf16_t* WRT = (LAS bf16_t*)(C.lds + P7_WRT); LAS bf16_t* H2T = (LAS bf16_t*)(C.lds + P7_H2T); LAS float* RED = (LAS float*)(C.lds + P7_RED);
    LAS float* GS = (LAS float*)(C.lds + P7_GS); LAS float* SH = GS + 3072;
    LAS int* LCt = (LAS int*)(C.lds + P7_LC); LAS int* BASE = (LAS int*)(C.lds + P7_BASE); LAS int* ENT = (LAS int*)(C.lds + P7_ENT);
    const bf16_t* Wr = (const bf16_t*)(ws + WS_WL + (size_t)l * WL_STRIDE + OFF_WR);
    build_mod_tables(C, a, l, 1, GS, SH);
    for (int i = C.tid; i < 32 * 128; i += 512) { const int r = i >> 7, c8 = (i & 127) * 8; *(LAS u32x4*)(WRT + r * P7_PITCH + c8) = *(const u32x4*)(Wr + r * 1024 + c8); }
    if (C.tid < 32) LCt[C.tid] = 0;
    __syncthreads();
    const bf16_t* X = (const bf16_t*)(ws + WS_X); bf16_t* H = (bf16_t*)(ws + WS_H);
    const int ntile = Tm / 16, fr = C.lane & 15, fq = C.lane >> 4;
    int it = 0;
    for (int tile = blockIdx.x; tile < ntile; tile += C.G, ++it) {
#pragma unroll
        for (int rr = 0; rr < 2; ++rr) {
            const int rl = C.wave * 2 + rr, row = tile * 16 + rl, r = row < TLAT ? (row >> 13) : 2;
            f32x4 v[4]; float s = 0.f;
#pragma unroll
            for (int j = 0; j < 4; ++j) { v[j] = bf4_to_f32x4(*(const u32x2*)(X + (size_t)row * D + 4 * C.lane + 256 * j)); s += (v[j][0] * v[j][0] + v[j][1] * v[j][1]) + (v[j][2] * v[j][2] + v[j][3] * v[j][3]); }
            const float rstd = __builtin_amdgcn_rsqf(wave_sum(s) * (1.f / 1024.f) + EPS);
#pragma unroll
            for (int j = 0; j < 4; ++j) { const int c = 4 * C.lane + 256 * j; const f32x4 g = *(const LAS f32x4*)(GS + r * 1024 + c), h = *(const LAS f32x4*)(SH + r * 1024 + c);
                const f32x4 y = v[j] * rstd * g + h; u32x2 w; w.x = cvt_pk_bf16(y[0], y[1]); w.y = cvt_pk_bf16(y[2], y[3]);
                *(unsigned*)((unsigned char*)H + (size_t)row * D + c) = pack_fp8x4_sat(y[0], y[1], y[2], y[3]); *(LAS u32x2*)(H2T + rl * P7_PITCH + c) = w; }
        }
        __syncthreads();
        {
            f32x4 acc0 = (f32x4){0.f, 0.f, 0.f, 0.f}, acc1 = acc0;
#pragma unroll
            for (int s = 0; s < 4; ++s) { const int k0 = C.wave * 128 + s * 32 + fq * 8;
                const bf16x8 av = *(const LAS bf16x8*)(H2T + fr * P7_PITCH + k0);
                const bf16x8 b0 = *(const LAS bf16x8*)(WRT + fr * P7_PITCH + k0), b1 = *(const LAS bf16x8*)(WRT + (16 + fr) * P7_PITCH + k0);
                acc0 = __builtin_amdgcn_mfma_f32_16x16x32_bf16(av, b0, acc0, 0, 0, 0); acc1 = __builtin_amdgcn_mfma_f32_16x16x32_bf16(av, b1, acc1, 0, 0, 0); }
#pragma unroll
            for (int j = 0; j < 4; ++j) { RED[(C.wave * 16 + 4 * fq + j) * 32 + fr] = acc0[j]; RED[(C.wave * 16 + 4 * fq + j) * 32 + 16 + fr] = acc1[j]; }
        }
        __syncthreads();
        {
            const int rl = C.tid >> 5, e = C.tid & 31;
            float v = inp(in, I_BR)[l * NE + e];
#pragma unroll
            for (int w = 0; w < 8; ++w) v += RED[(w * 16 + rl) * 32 + e];
            float tv[4]; int ti[4];
#pragma unroll
            for (int k = 0; k < 4; ++k) { float mv = v; int mi = e;
#pragma unroll
                for (int off = 1; off < 32; off <<= 1) { const float ov = __shfl_xor(mv, off); const int oi = __shfl_xor(mi, off); if (ov > mv || (ov == mv && oi < mi)) { mv = ov; mi = oi; } }
                tv[k] = mv; ti[k] = mi; if (e == mi) v = -INFINITY; }
            const float e1 = fast_exp(tv[1] - tv[0]), e2 = fast_exp(tv[2] - tv[0]), e3 = fast_exp(tv[3] - tv[0]), inv = 1.f / (1.f + e1 + e2 + e3);
            if (e < 4) { const int me = e == 0 ? ti[0] : e == 1 ? ti[1] : e == 2 ? ti[2] : ti[3]; const float mw = (e == 0 ? 1.f : e == 1 ? e1 : e == 2 ? e2 : e3) * inv;
                const int rank = atomicAdd((int*)(LCt + me), 1);
                const int idx = (it * 16 + rl) * 4 + e; ENT[idx * 3] = me; ENT[idx * 3 + 1] = rank; ENT[idx * 3 + 2] = __float_as_int(mw); }
        }
        __syncthreads();
    }
    if (C.tid < 32) { const int n = LCt[C.tid]; BASE[C.tid] = n ? (int)atomicAdd((unsigned*)(ws + WS_CTL) + CW_CNT + (l * 32 + C.tid) * 64, (unsigned)n) : 0; }
    __syncthreads();
    unsigned* TOKE = (unsigned*)(ws + WS_TOKE);
    for (int i = C.tid; i < it * 64; i += 512) { const int iti = i >> 6, rl = (i >> 2) & 15, k = i & 3, row = (blockIdx.x + iti * C.G) * 16 + rl;
        const int me = ENT[i * 3], pos = BASE[me] + ENT[i * 3 + 1]; TOKE[row * 4 + k] = (unsigned)me | ((unsigned)pos << 5);
        ((u32x2*)(ws + WS_LIST))[(size_t)me * LCAP + pos] = (u32x2){(unsigned)row, (unsigned)ENT[i * 3 + 2]}; }
}
__device__ __forceinline__ void build_tp(const Ctx& C0, int l, LAS int* tp) {
    const Ctx C = fresh(C0); unsigned char* ws = C.ws; InArr in = C.in; (void)ws; (void)in;
    if (C.tid < 64) {
        const unsigned* cnt = (const unsigned*)(ws + WS_CTL) + CW_CNT + l * 32 * 64; const int e = C.tid & 31;
        const unsigned n = cnt[e * 64]; int sc = (int)((n + 255u) >> 8);
#pragma unroll
        for (int off = 1; off < 32; off <<= 1) { const int o = __shfl_up(sc, off, 32); if (e >= off) sc += o; }
        if (C.tid < 32) { tp[e + 1] = sc; tp[33 + e] = (int)n; if (e == 0) tp[0] = 0; } }
    __syncthreads();
}
__device__ __forceinline__ void phase_combine(const Ctx& C0, const Args& a, int l, int Tm) {
    const Ctx C = fresh(C0); unsigned char* ws = C.ws; InArr in = C.in; (void)ws; (void)in;
    LAS int* tp = (LAS int*)(C.lds); LAS float* G2 = (LAS float*)(C.lds + 1024); LAS float* GS = G2 + 3072; LAS float* SH = GS + 3072;
    build_tp(C, l, tp);
    const float* MOD = (const float*)(ws + WS_MOD);
    for (int i = C.tid; i < 3072; i += 512) G2[i] = MOD[(size_t)(l * 3 + (i >> 10)) * 6144 + 5120 + (i & 1023)];
    if (l == 0) build_mod_tables(C, a, 1, 0, GS, SH);
    else for (int i = C.tid; i < 1024; i += 512) GS[i] = inp(in, I_FN)[i];
    __syncthreads();
    bf16_t* X = (bf16_t*)(ws + WS_X); bf16_t* H = (bf16_t*)(ws + WS_H); const bf16_t* Y = (const bf16_t*)(ws + WS_XS);
    const unsigned* TOKE = (const unsigned*)(ws + WS_TOKE);
    static_assert(Y_F8 == 1, "combine reads Y as e4m3 x8");
    for (int row0 = blockIdx.x * 8 + C.wave; row0 < Tm; row0 += C.G * 16) {
        const int nrow = (row0 + C.G * 8 < Tm) ? 2 : 1;
        unsigned te[2][4];
#pragma unroll
        for (int q = 0; q < 2; ++q) { const int row = (q < nrow) ? row0 + q * C.G * 8 : row0;
#pragma unroll
            for (int k = 0; k < 4; ++k) te[q][k] = TOKE[row * 4 + k]; }
        unsigned yw[2][4][4]; u32x2 xw[2][4];
#pragma unroll
        for (int q = 0; q < 2; ++q) { const int row = (q < nrow) ? row0 + q * C.G * 8 : row0;
#pragma unroll
            for (int j = 0; j < 4; ++j) { const int c = 4 * C.lane + 256 * j;
#pragma unroll
                for (int k = 0; k < 4; ++k) { const int slot = tp[te[q][k] & 31] * 256 + (int)(te[q][k] >> 5); yw[q][j][k] = *(const unsigned*)((const unsigned char*)Y + (size_t)slot * D + c); }
                xw[q][j] = *(const u32x2*)(X + (size_t)row * D + c); } }
#pragma unroll
        for (int q = 0; q < 2; ++q) { if (q < nrow) { const int row = row0 + q * C.G * 8, r = row < TLAT ? (row >> 13) : 2;
            f32x4 v[4];
#pragma unroll
            for (int j = 0; j < 4; ++j) { const int c = 4 * C.lane + 256 * j; f32x4 y = (f32x4){0.f, 0.f, 0.f, 0.f};
#pragma unroll
                for (int k = 0; k < 4; ++k) { const unsigned w = yw[q][j][k];
                    const f32x2 lo = __builtin_amdgcn_cvt_pk_f32_fp8((int)w, false), hi2 = __builtin_amdgcn_cvt_pk_f32_fp8((int)w, true); y += (f32x4){lo[0], lo[1], hi2[0], hi2[1]} * 0.125f; }
                v[j] = bf4_to_f32x4(xw[q][j]) + *(const LAS f32x4*)(G2 + r * 1024 + c) * y; }
            if (l == 0) {
#pragma unroll
                for (int j = 0; j < 4; ++j) { u32x2 w; w.x = cvt_pk_bf16(v[j][0], v[j][1]); w.y = cvt_pk_bf16(v[j][2], v[j][3]); *(u32x2*)(X + (size_t)row * D + 4 * C.lane + 256 * j) = w; }
                norm_store_bf16(v, GS + r * 1024, SH + r * 1024, H + (size_t)row * (G1_F8 ? D / 2 : D), C.lane);
            } else {
                float s2 = 0.f;
#pragma unroll
                for (int j = 0; j < 4; ++j) s2 += (v[j][0] * v[j][0] + v[j][1] * v[j][1]) + (v[j][2] * v[j][2] + v[j][3] * v[j][3]);
                const float rstd = __builtin_amdgcn_rsqf(wave_sum(s2) * (1.f / 1024.f) + EPS);
#pragma unroll
                for (int j = 0; j < 4; ++j) { const int c = 4 * C.lane + 256 * j; *(f32x4*)(a.out + (size_t)row * D + c) = v[j] * rstd * *(const LAS f32x4*)(GS + c); }
            } } }
    }
}

__device__ __forceinline__ void ph_g1(const Ctx& C, LAS unsigned char* ldsl, int l) {
    unsigned char* ws = opq(C.ws); unsigned char* wl = ws + WS_WL + (size_t)l * WL_STRIDE;
    pg8::TileOrderT<G1_F8 != 0> S; S.init(ws + WS_H, G1_F8 ? D / 2 : D, wl + OFF_WIN, G1_F8 ? D / 2 : D, T / 256, DINP / 256, C.G, opq_i(blockIdx.x));
    EpiZ E{(bf16_t*)(ws + WS_Z), (float*)(ws + WS_SSQ)};
    pg8::gemm_phase<EpiZ, pg8::TileOrderT<G1_F8 != 0>, G1_F8 != 0>(ldsl, opq_i(G1_F8 ? D / 2 : D), S, E);
}
__device__ __forceinline__ void ph_g2(const Ctx& C, LAS unsigned char* ldsl, int l) {
    unsigned char* ws = opq(C.ws); unsigned char* wl = ws + WS_WL + (size_t)l * WL_STRIDE;
    pg8::TileOrder S; S.init(ws + WS_Z + ZC_CQ * 2, DINP, wl + OFF_WUQ, 256, (l == 0) ? T / 256 : TLAT / 256, NQ / 256, C.G, blockIdx.x);
    EpiQ E{(bf16_t*)(ws + WS_Q), (const float*)(ws + WS_SSQ), (const float*)(ws + WS_TAB)};
    pg8::gemm_phase<EpiQ, pg8::TileOrder>(ldsl, opq_i(256), S, E);
}
__device__ __forceinline__ void ph_g3(const Ctx& C, LAS unsigned char* ldsl, int l) {
    unsigned char* ws = opq(C.ws); unsigned char* wl = ws + WS_WL + (size_t)l * WL_STRIDE;
    pg8::TileOrder S; S.init(ws + WS_Z + ZC_CKV * 2, DINP, wl + OFF_WUKV, 128, T / 256, NKV / 256, C.G, (blockIdx.x + 128) % C.G);
    EpiKV E{(bf16_t*)(ws + WS_KV), (const float*)(ws + WS_SSQ) + (size_t)T * 4, ws + WS_K8};
    pg8::gemm_phase<EpiKV, pg8::TileOrder>(ldsl, opq_i(128), S, E);
}
__device__ __forceinline__ void ph_attn(const Ctx& C0, int l) {
    const Ctx C = fresh(C0); unsigned char* ws = C.ws;
    const unsigned char* Q = ws + WS_Q; const bf16_t* KV = (const bf16_t*)(ws + WS_KV); const unsigned char* KPE = ws + WS_KPE; bf16_t* AL = (bf16_t*)(ws + WS_AL);
    NoTick E;
    const int nunit = (l == 0) ? 528 : 512;
    const int vcu = (C.G % 8 == 0) ? (int)(blockIdx.x % 8) * (C.G / 8) + (int)(blockIdx.x / 8) : (int)blockIdx.x;
    for (int uidx = vcu; uidx < nunit; uidx += C.G) {
        int b, h, qrow, NT;
        if (uidx < 512) { const int bh = uidx >> 5, qb = uidx & 31; b = bh >> 3; h = bh & 7; qrow = b * SEQ + qb * 256; NT = 132; }
        else { const int u2 = uidx - 512; b = u2 >> 3; h = u2 & 7; qrow = TLAT + b * CTXL; NT = 4; }
        att::attn_unit(Q + (size_t)qrow * NQ + h * 192, ws + WS_K8 + h * 128, ws + WS_KV + (size_t)(b * 8 + h) * 128 * KTOT, KPE, TLAT + b * CTXL, b * SEQ, NT, NT == 132 ? (vcu & 31) * 4 : 0,
                       MRG_F8 ? (bf16_t*)((unsigned char*)AL + (size_t)qrow * 2048 + h * 128) : AL + (size_t)qrow * 2048 + h * 128, (char*)C.lds, E);
    }
}
__device__ __forceinline__ void ph_merge(const Ctx& C, LAS unsigned char* ldsl, int l) {
    unsigned char* ws = opq(C.ws); InArr in = opq_in(C.in); unsigned char* wl = ws + WS_WL + (size_t)l * WL_STRIDE;
    constexpr int EU = MRG_F8 ? 2 : 1;
    pg8::TileOrderT<MRG_F8 != 0> S; S.init(ws + WS_AL, 2048 / EU, wl + OFF_WM, 2048 / EU, (l == 0) ? T / 256 : TLAT / 256, D / 256, C.G, blockIdx.x, 1, 1024 / EU);
    EpiM E{(const bf16_t*)(ws + WS_Z), inp(in, I_BBG) + l * 2048, (bf16_t*)(ws + WS_M)};
    pg8::gemm_phase<EpiM, pg8::TileOrderT<MRG_F8 != 0>, MRG_F8 != 0>(ldsl, opq_i(D / EU), S, E);
}
__device__ __forceinline__ void ph_wout(const Ctx& C, LAS unsigned char* ldsl, int l) {
    unsigned char* ws = opq(C.ws); InArr in = opq_in(C.in); unsigned char* wl = ws + WS_WL + (size_t)l * WL_STRIDE;
    constexpr int EU = MRG_F8 ? 2 : 1;
    pg8::TileOrderT<MRG_F8 != 0> S; S.init(ws + WS_M, D / EU, wl + OFF_WOUT, D / EU, (l == 0) ? T / 256 : TLAT / 256, D / 256, C.G, blockIdx.x);
    EpiX E{inp(in, I_X), inp(in, I_CTX), (const float*)(ws + WS_MOD) + (size_t)l * 3 * 6144 + 2048, (bf16_t*)(ws + WS_X), l != 0};
    pg8::gemm_phase<EpiX, pg8::TileOrderT<MRG_F8 != 0>, MRG_F8 != 0>(ldsl, opq_i(D / EU), S, E);
}
__device__ __forceinline__ void ph_moe1(const Ctx& C, LAS unsigned char* ldsl, int l) {
    unsigned char* ws = opq(C.ws); InArr in = opq_in(C.in);
    LAS int* tp = (LAS int*)(ldsl + 140000); build_tp(C, l, tp);
    pg8::MoeOrder<true> S; S.A = (const char*)(ws + WS_H); S.B = (const char*)(ws + WS_WGU + (size_t)l * WGU_STRIDE); S.lda = D / 2; S.ldb = D / 2; S.tp = tp; S.NT = 8; S.G = C.G; S.c = (C.G % 8 == 0) ? (int)(blockIdx.x % 8) * (C.G / 8) + (int)(blockIdx.x / 8) : (int)blockIdx.x; S.total = tp[32] * 8; S.list = (const u32x2*)(ws + WS_LIST);
    S.build_lists((LAS int*)(ldsl + 141056), C.tid);
    EpiACT E{(unsigned char*)(ws + WS_ACT), inp(in, I_BEG) + l * NE * D, inp(in, I_BEU) + l * NE * D};
    pg8::gemm_phase<EpiACT, pg8::MoeOrder<true>, true>(ldsl, opq_i(D / 2), S, E);
}
__device__ __forceinline__ void ph_moe2(const Ctx& C, LAS unsigned char* ldsl, int l) {
    unsigned char* ws = opq(C.ws); InArr in = opq_in(C.in);
    LAS int* tp = (LAS int*)(ldsl + 140000); build_tp(C, l, tp);
    pg8::MoeOrder<true> S; S.A = (const char*)(ws + WS_ACT); S.B = (const char*)(ws + WS_WD + (size_t)l * WD_STRIDE); S.lda = MOE2_F8 ? D / 2 : D; S.ldb = MOE2_F8 ? D / 2 : D; S.tp = tp; S.NT = 4; S.G = C.G; S.c = (C.G % 8 == 0) ? (int)(blockIdx.x % 8) * (C.G / 8) + (int)(blockIdx.x / 8) : (int)blockIdx.x; S.total = tp[32] * 4; S.list = nullptr;
    S.build_lists((LAS int*)(ldsl + 141056), C.tid);
    EpiY E{(bf16_t*)(ws + WS_XS), inp(in, I_BED) + l * NE * D, (const u32x2*)(ws + WS_LIST)};
    pg8::gemm_phase<EpiY, pg8::MoeOrder<true>, MOE2_F8 != 0>(ldsl, opq_i(MOE2_F8 ? D / 2 : D), S, E);
}

constexpr int NPHASE = 20;
__global__ void __launch_bounds__(512, 2) fwd(Args a) {
    extern __shared__ __attribute__((aligned(16))) unsigned char lds_raw[];
    Ctx C; C.lds = lds_raw; C.ws = a.ws; C.tid = threadIdx.x; C.lane = C.tid & 63; C.wave = __builtin_amdgcn_readfirstlane(C.tid >> 6); C.G = gridDim.x; C.in = (InArr)__builtin_amdgcn_kernarg_segment_ptr();
    LAS unsigned char* ldsl = (LAS unsigned char*)lds_raw;
    volatile LAS unsigned* MISC = (volatile LAS unsigned*)(ldsl + MISC_OFF);
    if (C.tid < 64) MISC[C.tid] = 0u;
    __syncthreads();
    const bool use_bar = (a.ph_hi - a.ph_lo) > 1;
    XcdBarrier bar; bar.bar = (unsigned*)(C.ws + WS_CTL) + CW_BAR; bar.x = 0; bar.st = MISC + 8;
    if (use_bar) bar = xcd_barrier_post((unsigned*)(C.ws + WS_CTL) + CW_BAR, MISC + 8);
    const int lo = a.ph_lo, hi = a.ph_hi;
#ifndef PH_MASK
#define PH_MASK 0xffffffffu
#endif
#define PHBIT(k) ((k) < 2 ? (k) : 2 + ((k) - 2) % 9)
#define IN(k) (((PH_MASK >> PHBIT(k)) & 1u) && lo <= (k) && (k) < hi)
#define SEAM(k) do { if (lo <= (k) && (k) + 1 < hi) xcd_barrier(bar); } while (0)

#ifndef REP_MASK
#define REP_MASK 0u
#endif
#define RUN(bit, stmt) do { stmt; if ((REP_MASK >> (bit)) & 1u) { __syncthreads(); stmt; } } while (0)
    if (IN(0)) { phase_adaln(C, a); } SEAM(0);
    if (IN(1)) { RUN(0, phase_prologue(C, a)); } SEAM(1);
#pragma unroll 1
    for (int l = 0; l < 2; ++l) {
        const int pb = 2 + 9 * l;
        const int Tm = (l == 0) ? T : TLAT;
        if (IN(pb + 0)) { RUN(1, ph_g1(C, ldsl, l)); } SEAM(pb + 0);
        if (IN(pb + 1)) { RUN(2, ph_g2(C, ldsl, l)); RUN(3, ph_g3(C, ldsl, l)); RUN(4, lru_pass<1>(C, a, l)); RUN(5, kpe_rope(C)); } SEAM(pb + 1);
        if (IN(pb + 2)) { RUN(7, ph_attn(C, l)); RUN(8, lru_pass<2>(C, a, l)); } SEAM(pb + 2);
        if (IN(pb + 3)) { RUN(9, ph_merge(C, ldsl, l)); } SEAM(pb + 3);
        if (IN(pb + 4)) { ph_wout(C, ldsl, l); } SEAM(pb + 4);
        if (IN(pb + 5)) { phase_router(C, a, l, Tm); } SEAM(pb + 5);
        if (IN(pb + 6)) { RUN(13, ph_moe1(C, ldsl, l)); } SEAM(pb + 6);
        if (IN(pb + 7)) { RUN(14, ph_moe2(C, ldsl, l)); } SEAM(pb + 7);
        if (IN(pb + 8)) { phase_combine(C, a, l, Tm); } SEAM(pb + 8);
    }
#undef IN
#undef SEAM
}

extern "C" void kernel_launch(void* const* d_in, const int* in_sizes, int n_in, void* d_out, int out_size, void* d_ws, size_t ws_size, hipStream_t stream) {
    static int grid = 0;
    if (grid == 0) {
        if (n_in != 33 || in_sizes[0] != TLAT * D || out_size != TLAT * D || ws_size < WS_END) {
            fprintf(stderr, "kernel_launch: shape/workspace mismatch: n_in %d in0 %d out %d ws %zu (need >= %zu)\n", n_in, n_in > 0 ? in_sizes[0] : -1, out_size, ws_size, (size_t)WS_END); grid = -1; return; }
        int dev = 0, cus = 0, per_cu = 0;
        if (hipGetDevice(&dev) != hipSuccess || hipDeviceGetAttribute(&cus, hipDeviceAttributeMultiprocessorCount, dev) != hipSuccess) { grid = -1; return; }
        if (hipFuncSetAttribute((const void*)fwd, hipFuncAttributeMaxDynamicSharedMemorySize, LDS_BYTES) != hipSuccess) { fprintf(stderr, "kernel_launch: hipFuncSetAttribute failed\n"); grid = -1; return; }
        if (hipOccupancyMaxActiveBlocksPerMultiprocessor(&per_cu, (const void*)fwd, 512, LDS_BYTES) != hipSuccess || per_cu < 1) fprintf(stderr, "kernel_launch: occupancy query reports %d\n", per_cu);
        (void)hipGetLastError();
        grid = cus;
    }
    if (grid < 0) return;
    (void)hipMemsetAsync((char*)d_ws + WS_CTL, 0, CTL_BYTES, stream);
    Args a{};
    for (int i = 0; i < 33; ++i) a.in[i] = (const float*)d_in[i];
    a.out = (float*)d_out; a.ws = (unsigned char*)d_ws;
#if MULTI_LAUNCH
    for (int p = 0; p < NPHASE; ++p) { a.ph_lo = p; a.ph_hi = p + 1; hipLaunchKernelGGL(fwd, dim3(grid), dim3(512), LDS_BYTES, stream, a); }
#else
    a.ph_lo = 0; a.ph_hi = NPHASE; hipLaunchKernelGGL(fwd, dim3(grid), dim3(512), LDS_BYTES, stream, a);
#endif
    const hipError_t le = hipPeekAtLastError();
    if (le != hipSuccess) fprintf(stderr, "kernel_launch: launch failed: %s\n", hipGetErrorName(le));
}
```

```cpp
#include <hip/hip_runtime.h>
#include <cstdio>
#include <cstdint>

#ifndef G1_F8
#define G1_F8 0
#endif
#ifndef PG8_SP2
#define PG8_SP2 true
#endif
#ifndef MRG_F8
#define MRG_F8 0
#endif
#ifndef Y_F8
#define Y_F8 1
#endif
#ifndef MOE2_F8
#define MOE2_F8 1
#endif
#ifndef MULTI_LAUNCH
#define MULTI_LAUNCH 0
#endif

#define LAS __attribute__((address_space(3)))
typedef unsigned short bf16_t;
typedef short bf16x8 __attribute__((ext_vector_type(8)));
typedef short s16x4 __attribute__((ext_vector_type(4)));
typedef float f32x4 __attribute__((ext_vector_type(4)));
typedef float f32x2 __attribute__((ext_vector_type(2)));
typedef float f32x16 __attribute__((ext_vector_type(16)));
typedef unsigned u32x4 __attribute__((ext_vector_type(4)));
typedef unsigned u32x2 __attribute__((ext_vector_type(2)));

constexpr int D = 1024, SEQ = 8192, CTXL = 256;
constexpr int TLAT = 16384, T = 16896;
constexpr int DIN = 4544, DINP = 4608;
constexpr int ZC_CQ = 0, ZC_CKV = 256, ZC_KPE = 384, ZC_XR = 448, ZC_GR = 1472, ZC_GA = 2496, ZC_GL = 3520;
constexpr int NQ = 1536, NKV = 2048;
constexpr int NE = 32, NSLOT = 75776;
constexpr float EPS = 1e-6f;
constexpr int NCHUNK = T / 64;
constexpr int KTOT = CTXL + SEQ;

constexpr size_t MiB = 1u << 20;
constexpr size_t WS_CTL = 0, CTL_BYTES = 1 * MiB;
constexpr size_t WS_MOD = 1 * MiB;
constexpr size_t WS_TAB = 1 * MiB + 256 * 1024;
constexpr size_t WS_LRUC = 1 * MiB + 320 * 1024;
constexpr size_t WS_SSQ = 2 * MiB;
constexpr size_t WS_SUM = 3 * MiB;
constexpr size_t WS_CAR = 8 * MiB;
constexpr size_t WS_TOKE = 11 * MiB;
constexpr size_t WS_TOKW = 11 * MiB + 512 * 1024;
constexpr size_t WS_SLOTW = 12 * MiB;
constexpr size_t WS_WL = 16 * MiB, WL_STRIDE = 20 * MiB;
constexpr size_t OFF_WIN = 0, OFF_WUQ = 9 * MiB, OFF_WUKV = 10 * MiB, OFF_WM = 11 * MiB, OFF_WOUT = 15 * MiB, OFF_WR = 17 * MiB, OFF_LW = 17 * MiB + 512 * 1024;
constexpr size_t WS_WGU = 56 * MiB, WGU_STRIDE = 128 * MiB;
constexpr size_t WS_WD = 312 * MiB, WD_STRIDE = 64 * MiB;
constexpr size_t WS_X = 440 * MiB;
constexpr size_t WS_H = 506 * MiB;
constexpr size_t WS_Z = 539 * MiB;
constexpr size_t WS_Q = 688 * MiB;
constexpr size_t WS_KV = 738 * MiB;
constexpr size_t WS_KPE = 804 * MiB;
constexpr size_t WS_AL = 807 * MiB;
constexpr size_t WS_M = 873 * MiB;
constexpr size_t WS_XS = 539 * MiB;
constexpr size_t WS_ACT = 688 * MiB;
constexpr size_t WS_LIST = 906 * MiB;
constexpr int LCAP = T + 256;
constexpr size_t WS_K8 = 911 * MiB;
constexpr size_t WS_END = 928 * MiB;
constexpr int CW_BAR = 4096, CW_CNT = 8192;

constexpr int LDS_BYTES = 163840, MISC_OFF = 163584;

__device__ __forceinline__ unsigned cvt_pk_bf16(float lo, float hi) { unsigned r; asm volatile("v_cvt_pk_bf16_f32 %0, %1, %2" : "=v"(r) : "v"(lo), "v"(hi)); return r; }
typedef int v8i __attribute__((ext_vector_type(8)));
typedef int i32x4 __attribute__((ext_vector_type(4)));
__device__ __forceinline__ unsigned pack_fp8x4(float a, float b, float c, float d) { int w = __builtin_amdgcn_cvt_pk_fp8_f32(a, b, 0, false); w = __builtin_amdgcn_cvt_pk_fp8_f32(c, d, w, true); return (unsigned)w; }
__device__ __forceinline__ unsigned pack_fp8x4_sat(float a, float b, float c, float d) {
    return pack_fp8x4(__builtin_amdgcn_fmed3f(a, -448.f, 448.f), __builtin_amdgcn_fmed3f(b, -448.f, 448.f), __builtin_amdgcn_fmed3f(c, -448.f, 448.f), __builtin_amdgcn_fmed3f(d, -448.f, 448.f)); }
constexpr float F8_WSCALE = 32.f, F8_WINV = 1.f / 32.f;
constexpr float F8_SA = 64.f, F8_SL = 1.f, F8_SM = 4.f;
__device__ __forceinline__ float bf_lo(unsigned w) { return __uint_as_float(w << 16); }
__device__ __forceinline__ float bf_hi(unsigned w) { return __uint_as_float(w & 0xffff0000u); }
__device__ __forceinline__ f32x4 bf4_to_f32x4(u32x2 w) { return (f32x4){bf_lo(w.x), bf_hi(w.x), bf_lo(w.y), bf_hi(w.y)}; }
__device__ __forceinline__ float bf1(bf16_t h) { return __uint_as_float(((unsigned)h) << 16); }
constexpr float LOG2E = 1.4426950408889634f;
__device__ __forceinline__ float fast_exp(float x) { return __builtin_amdgcn_exp2f(x * 1.4426950408889634f); }
__device__ __forceinline__ float sigmoidf_(float x) { return __builtin_amdgcn_rcpf(1.f + fast_exp(-x)); }
__device__ __forceinline__ float gelu_tanh(float x) { const float z = 0.7978845608028654f * (x + 0.044715f * x * x * x); return x * sigmoidf_(2.f * z); }
__device__ __forceinline__ float wave_sum(float v) {
#pragma unroll
    for (int o = 1; o < 64; o <<= 1) v += __shfl_xor(v, o);
    return v;
}

#define GAS __attribute__((address_space(1)))
#define CAS __attribute__((address_space(4)))
typedef const float* cfptr;
typedef const cfptr CAS* InArr;
template <class P> __device__ __forceinline__ P* opq(P* p) {
    const unsigned long long v = (unsigned long long)p; unsigned lo = __builtin_amdgcn_readfirstlane((unsigned)v), hi = __builtin_amdgcn_readfirstlane((unsigned)(v >> 32));
    asm volatile("" : "+s"(lo), "+s"(hi));
    return (P*)(GAS char*)(((unsigned long long)hi << 32) | lo);
}
__device__ __forceinline__ InArr opq_in(InArr p) {
    const unsigned long long v = (unsigned long long)p; unsigned lo = __builtin_amdgcn_readfirstlane((unsigned)v), hi = __builtin_amdgcn_readfirstlane((unsigned)(v >> 32));
    asm volatile("" : "+s"(lo), "+s"(hi));
    return (InArr)(((unsigned long long)hi << 32) | lo);
}
__device__ __forceinline__ const float* inp(InArr in, int i) { return (const float*)(const GAS float*)in[i]; }
__device__ __forceinline__ int opq_v(int v) { asm volatile("" : "+v"(v)); return v; }
__device__ __forceinline__ int opq_i(int v) { v = __builtin_amdgcn_readfirstlane(v); asm volatile("" : "+s"(v)); return v; }

#define XB_TMO      128
#define XB_XCNT(j)  (256  + 64 * (j))
#define XB_XSUB(j)  (1280 + 64 * (j))
#define XB_XGEN(j)  (2304 + 64 * (j))
#define XB_TOP      3328
#define XB_TOPGEN   3392
#define XCD_BAR_WORDS 3456
#define XB_SPIN_CAP (1u << 22)
__device__ __forceinline__ unsigned xb_ld(unsigned* p)              { return __hip_atomic_load(p, __ATOMIC_RELAXED, __HIP_MEMORY_SCOPE_AGENT); }
__device__ __forceinline__ unsigned xb_add(unsigned* p, unsigned v) { return __hip_atomic_fetch_add(p, v, __ATOMIC_RELAXED, __HIP_MEMORY_SCOPE_AGENT); }
__device__ __forceinline__ unsigned xb_xcc_id() { return (unsigned)__builtin_amdgcn_s_getreg((3 << 11) | 20) & 0xFu; }
#define XB_SPIN(cond, bar) do { unsigned _sp = 0; while (cond) { __builtin_amdgcn_s_sleep(1); \
    if ((++_sp & 255u) == 0u) { if (xb_ld(&(bar)[XB_TMO])) break; if (_sp > XB_SPIN_CAP) { atomicAdd(&(bar)[XB_TMO], 1u); break; } } } } while (0)
struct XcdBarrier { unsigned* bar; unsigned x; volatile LAS unsigned* st; };
__device__ __forceinline__ XcdBarrier xcd_barrier_post(unsigned* bar, volatile LAS unsigned* st) {
    XcdBarrier b; b.bar = bar; b.x = xb_xcc_id(); b.st = st;
    if (threadIdx.x == 0) (void)xb_add(&bar[XB_XCNT(b.x)], 1u);
    return b;
}
__device__ __forceinline__ void xcd_barrier_complete(unsigned* bar, unsigned x, unsigned& nloc, unsigned& nx) {
    const unsigned G = gridDim.x * gridDim.y * gridDim.z;
    unsigned sum, cnt, mine, sp = 0u;
    for (;;) {
        sum = 0u; cnt = 0u; mine = 0u;
#pragma unroll 1
        for (unsigned j = 0; j < 16; ++j) { const unsigned c = xb_ld(&bar[XB_XCNT(j)]); sum += c; cnt += (c > 0u) ? 1u : 0u; mine = (j == x) ? c : mine; }
        if (sum == G) break;
        __builtin_amdgcn_s_sleep(1);
        if ((++sp & 255u) == 0u) { if (xb_ld(&bar[XB_TMO])) break; if (sp > XB_SPIN_CAP) { atomicAdd(&bar[XB_TMO], 1u); break; } }
    }
    nloc = mine > 0u ? mine : 1u; nx = cnt > 0u ? cnt : 1u;
}
__device__ __forceinline__ void xcd_barrier(const XcdBarrier& b) {
    asm volatile("s_waitcnt vmcnt(0)" ::: "memory");
    __syncthreads();
    if (threadIdx.x == 0) {
        unsigned* bar = b.bar;
        __builtin_amdgcn_s_waitcnt(0);
        unsigned nloc = b.st[0], nx = b.st[1];
        if (nloc == 0u) { xcd_barrier_complete(bar, b.x, nloc, nx); b.st[0] = nloc; b.st[1] = nx; }
        const unsigned old = xb_add(&bar[XB_XSUB(b.x)], 1u);
        const unsigned gen = old / nloc;
        if (old + 1u == (gen + 1u) * nloc) {
            __builtin_amdgcn_fence(__ATOMIC_RELEASE, "agent");
            asm volatile("s_waitcnt vmcnt(0)" ::: "memory");
            const unsigned og = xb_add(&bar[XB_TOP], 1u);
            const unsigned tg = og / nx;
            if (og + 1u == (tg + 1u) * nx) xb_add(&bar[XB_TOPGEN], 1u);
            else XB_SPIN(xb_ld(&bar[XB_TOPGEN]) == tg, bar);
            __builtin_amdgcn_fence(__ATOMIC_ACQUIRE, "agent");
            xb_add(&bar[XB_XGEN(b.x)], 1u);
            asm volatile("s_waitcnt vmcnt(0)" ::: "memory");
        } else {
            XB_SPIN(xb_ld(&bar[XB_XGEN(b.x)]) == gen, bar);
            __builtin_amdgcn_fence(__ATOMIC_ACQUIRE, "agent");
            asm volatile("s_waitcnt vmcnt(0)" ::: "memory");
        }
    }
    __syncthreads();
}

namespace pg8 {
constexpr int BM = 256, BK = 64, HALF = 128, HTB = HALF * BK * 2, STAGE_BYTES = 8 * HTB, NXCD = 8, WGM = 8;
__host__ __device__ __forceinline__ int lds_byte(int r, int c) { const int st = (r >> 4) * 2 + (c >> 5), rr = r & 15, cc = c & 31, ob = rr * 64 + cc * 2; return st * 1024 + (ob ^ (((ob >> 9) & 1) << 5)); }
__host__ __device__ __forceinline__ void stage_rc(int b, int& R, int& C) { const int st = b / 1024, sb = b % 1024, swz = sb ^ (((sb >> 9) & 1) << 5); R = (st >> 1) * 16 + swz / 64; C = (st & 1) * 32 + (swz % 64) / 2; }
__host__ __device__ __forceinline__ void stage_rc8(int b, int& R, int& C) { const int st = b / 1024, sb = b % 1024, swz = sb ^ (((sb >> 9) & 1) << 5); R = (st >> 1) * 16 + swz / 64; C = (((swz % 64) / 16) * 32 + (st & 1) * 16) / 2; }
__device__ __forceinline__ v8i cat8(bf16x8 a, bf16x8 b) { const i32x4 x = __builtin_bit_cast(i32x4, a), y = __builtin_bit_cast(i32x4, b); return __builtin_shufflevector(x, y, 0, 1, 2, 3, 4, 5, 6, 7); }
__host__ __device__ __forceinline__ int perm32(int rho) { const int n = rho >> 4, i = rho & 15; return 8 * (i >> 2) + 4 * n + (i & 3); }
struct Unit { int pm, pn, aux, e, rl; };

template <bool GATHER_> struct TileOrderT {
    static constexpr bool GATHER = GATHER_;
    const char* A; const char* B; int lda, ldb;
    int nM, nN, nwg, G, c, dual, koff;
    __device__ void init(const void* A_, int lda_, const void* B_, int ldb_, int nM_, int nN_, int G_, int c_, int dual_ = 0, int koff_ = 0) {
        A = (const char*)A_; B = (const char*)B_; lda = lda_; ldb = ldb_; nM = nM_; nN = nN_; nwg = nM * nN; G = G_; c = c_; dual = dual_; koff = koff_; }
    __device__ __forceinline__ bool next(int i, Unit& u) const {
        const int ti = dual ? (i >> 1) : i; u.aux = dual ? (i & 1) : 0; u.e = 0; u.rl = 0;
        const long L = (long)ti * G + c; if (L >= nwg) return false;
        int wgid = (int)L; { const int q = nwg / NXCD, r = nwg % NXCD, xcd = wgid % NXCD, off = wgid / NXCD; wgid = (xcd < r ? xcd * (q + 1) : r * (q + 1) + (xcd - r) * q) + off; }
        const int nig = WGM * nN, gid = wgid / nig, fm = gid * WGM, gsz = (nM - fm) < WGM ? (nM - fm) : WGM;
        u.pm = fm + ((wgid % nig) % gsz); u.pn = (wgid % nig) / gsz; return true;
    }
    __device__ __forceinline__ const char* a_ptr(const Unit& u) const { return GATHER ? A : A + ((size_t)u.pm * BM * lda + (size_t)u.aux * koff) * 2; }
    __device__ __forceinline__ const char* b_ptr(const Unit& u) const { return B + ((size_t)u.pn * BM * ldb + (size_t)u.aux * koff) * 2; }
    __device__ __forceinline__ void gather(int ui, const int (&R)[2], const int (&Cc)[2], unsigned (&va)[2][2]) const {
        Unit u; (void)next(ui, u);
#pragma unroll
        for (int h = 0; h < 2; ++h)
#pragma unroll
            for (int i = 0; i < 2; ++i) va[h][i] = (unsigned)((u.pm * BM + h * 128 + R[i]) * lda + Cc[i] + u.aux * koff) * 2u;
    }
};
typedef TileOrderT<false> TileOrder;
template <bool GATHER_> struct MoeOrder {
    static constexpr bool GATHER = GATHER_;
    const char* A; const char* B; int lda, ldb; const LAS int* tp; int NT, G, c, total; const u32x2* list;
    __device__ __forceinline__ bool next(int i, Unit& u) const {
        const int L = i * G + c; if (L >= total) return false;
        int e = 0;
#pragma unroll 8
        for (int k = 0; k < 32; ++k) e += (tp[k + 1] * NT <= L) ? 1 : 0;
        const int t0 = tp[e], nte = tp[e + 1] - t0, rem = L - t0 * NT, pnl = rem / nte, rtl = rem - pnl * nte;
        u.pm = __builtin_amdgcn_readfirstlane(t0 + rtl); u.pn = __builtin_amdgcn_readfirstlane(e * NT + pnl); u.aux = 0; u.e = __builtin_amdgcn_readfirstlane(e); u.rl = __builtin_amdgcn_readfirstlane(rtl); return true;
    }
    __device__ __forceinline__ const char* a_ptr(const Unit& u) const { return GATHER ? A : A + (size_t)u.pm * BM * lda * 2; }
    __device__ __forceinline__ const char* b_ptr(const Unit& u) const { return B + (size_t)u.pn * BM * ldb * 2; }
    const LAS int* tokl;
    __device__ __forceinline__ void gather(int ui, const int (&R)[2], const int (&Cc)[2], unsigned (&va)[2][2]) const {
#pragma unroll
        for (int h = 0; h < 2; ++h)
#pragma unroll
            for (int i = 0; i < 2; ++i) va[h][i] = (unsigned)(tokl[ui * 256 + h * 128 + R[i]] * lda + Cc[i]) * 2u;
    }
    __device__ __forceinline__ void build_lists(LAS int* tl, int tid0) {
        const int tid = opq_v(tid0);
        for (int i = 0; ; i += 3) { Unit u[3]; bool ok[3]; int v[3];
#pragma unroll
            for (int j = 0; j < 3; ++j) { ok[j] = next(i + j, u[j]); v[j] = 0;
                if (ok[j] && tid < 256) { const int pos = u[j].rl * 256 + tid;
                    v[j] = list ? ((pos < tp[33 + u[j].e]) ? (int)((const unsigned*)(list + (size_t)u[j].e * LCAP + pos))[0] : 0) : u[j].pm * 256 + tid; } }
#pragma unroll
            for (int j = 0; j < 3; ++j) if (ok[j] && tid < 256) tl[(i + j) * 256 + tid] = v[j];
            if (!ok[2]) break; }
        tokl = tl; __syncthreads();
    }
};

template <class Epi, class Sched, bool F8 = false>
__device__ __forceinline__ void gemm_phase(LAS unsigned char* lds, int K, const Sched& S, const Epi& E) {
    const int tid = opq_v(threadIdx.x), wid = __builtin_amdgcn_readfirstlane(tid >> 6), lane = tid & 63, wr = wid >> 2, wc = wid & 3, fr = lane & 15, fq = lane >> 4;
    const int nt = K / BK;
    unsigned voffB[2], vaC[2][2], vaN[2][2]; int sR[2], sC[2];
    const size_t kstep = (size_t)(BK * 2);
    const size_t hstepB = (size_t)HALF * S.ldb * 2;
#pragma unroll
    for (int i = 0; i < 2; ++i) { int R, C; if (F8) stage_rc8(tid * 16 + i * 8192, R, C); else stage_rc(tid * 16 + i * 8192, R, C); const int Rb = Epi::PERM ? ((R & ~31) + perm32(R & 31)) : R; sR[i] = R; sC[i] = C;
        voffB[i] = (unsigned)(Rb * S.ldb + C) * 2u;
        vaC[0][i] = (unsigned)(R * S.lda + C) * 2u; vaC[1][i] = 0u; vaN[0][i] = 0u; vaN[1][i] = 0u; }
    const unsigned hstepA = Sched::GATHER ? 0u : (unsigned)HALF * (unsigned)S.lda * 2u;
    const unsigned ldsw = (unsigned)wid * 1024u;
    const int aoff = lds_byte(wr * 64 + fr, fq * 8), boff = lds_byte(wc * 32 + fr, fq * 8);
#define PG8_SA(b, h) (((b) * 2 + (h)) * HTB)
#define PG8_SB(b, h) ((4 + (b) * 2 + (h)) * HTB)
#define PG8_STAGE(bufoff, gbase, voff) do { _Pragma("unroll") for (int _i = 0; _i < 2; ++_i) \
        __builtin_amdgcn_global_load_lds((const unsigned*)((const char*)(gbase) + (voff)[_i]), (LAS unsigned*)(lds + (bufoff) + ldsw + _i * 8192), 16, 0, 0); } while (0)
#define PG8_STAGEA(bufoff, gbase, va, h) do { _Pragma("unroll") for (int _i = 0; _i < 2; ++_i) \
        __builtin_amdgcn_global_load_lds((const unsigned*)((const char*)(gbase) + (Sched::GATHER ? (va)[h][_i] : (va)[0][_i] + (h) * hstepA)), (LAS unsigned*)(lds + (bufoff) + ldsw + _i * 8192), 16, 0, 0); } while (0)
#define PG8_LDA(dst, b, h) do { _Pragma("unroll") for (int m = 0; m < 4; ++m) _Pragma("unroll") for (int k = 0; k < 2; ++k) dst[m][k] = *(const LAS bf16x8*)(lds + PG8_SA(b, h) + aoff + m * 2048 + k * 1024); } while (0)
#define PG8_LDB(dst, b, h) do { _Pragma("unroll") for (int n = 0; n < 2; ++n) _Pragma("unroll") for (int k = 0; k < 2; ++k) dst[n][k] = *(const LAS bf16x8*)(lds + PG8_SB(b, h) + boff + n * 2048 + k * 1024); } while (0)
#define PG8_MMA(ai, bj, At, Bt) do { __builtin_amdgcn_s_setprio(1); _Pragma("unroll") for (int m = 0; m < 4; ++m) _Pragma("unroll") for (int n = 0; n < 2; ++n) { \
        if constexpr (F8) acc[ai][bj][m][n] = __builtin_amdgcn_mfma_scale_f32_16x16x128_f8f6f4(cat8(Bt[n][0], Bt[n][1]), cat8(At[m][0], At[m][1]), acc[ai][bj][m][n], 0, 0, 0, 127, 0, 127); \
        else { _Pragma("unroll") for (int k = 0; k < 2; ++k) acc[ai][bj][m][n] = __builtin_amdgcn_mfma_f32_16x16x32_bf16(Bt[n][k], At[m][k], acc[ai][bj][m][n], 0, 0, 0); } } \
        __builtin_amdgcn_s_setprio(0); } while (0)
#define PG8_WAIT_V(n) asm volatile("s_waitcnt vmcnt(" #n ")" ::: "memory")
#define PG8_WAIT_L(n) asm volatile("s_waitcnt lgkmcnt(" #n ")" ::: "memory")
#define PG8_BAR __builtin_amdgcn_s_barrier()
#define PG8_SCHED __builtin_amdgcn_sched_barrier(0)
    Unit cur, nxt; int ui = 0;
    if (!S.next(0, cur)) return;
    f32x4 acc[2][2][4][2];
#pragma unroll
    for (int a = 0; a < 2; ++a)
#pragma unroll
        for (int b = 0; b < 2; ++b)
#pragma unroll
            for (int m = 0; m < 4; ++m)
#pragma unroll
                for (int n = 0; n < 2; ++n) acc[a][b][m][n] = (f32x4){0.f, 0.f, 0.f, 0.f};
    bf16x8 At[4][2], B0[2][2], B1[2][2];
    const char* cA = S.a_ptr(cur); const char* cB = S.b_ptr(cur);
    if constexpr (Sched::GATHER) { S.gather(0, sR, sC, vaC);
#pragma unroll
        for (int h = 0; h < 2; ++h)
#pragma unroll
            for (int i = 0; i < 2; ++i) asm volatile("" : "+v"(vaC[h][i])); }
    constexpr bool SP2 = PG8_SP2;
    if constexpr (SP2) {
        PG8_STAGE(PG8_SB(0, 0), cB, voffB); PG8_STAGE(PG8_SB(0, 1), cB + hstepB, voffB); PG8_STAGEA(PG8_SA(0, 0), cA, vaC, 0); PG8_STAGEA(PG8_SA(0, 1), cA, vaC, 1);
        if (wr == 1) PG8_BAR;
        PG8_WAIT_V(2); PG8_BAR;
        PG8_STAGE(PG8_SB(1, 0), cB + kstep, voffB); PG8_STAGEA(PG8_SA(1, 0), cA + kstep, vaC, 0); PG8_STAGE(PG8_SB(1, 1), cB + hstepB + kstep, voffB);
        PG8_WAIT_V(6); PG8_BAR;
    } else {
    PG8_STAGE(PG8_SB(0, 0), cB, voffB); PG8_STAGEA(PG8_SA(0, 0), cA, vaC, 0); PG8_STAGE(PG8_SB(0, 1), cB + hstepB, voffB); PG8_STAGEA(PG8_SA(0, 1), cA, vaC, 1);
    if (wr == 1) PG8_BAR;
    PG8_WAIT_V(4); PG8_BAR;
    PG8_STAGE(PG8_SB(1, 0), cB + kstep, voffB); PG8_STAGEA(PG8_SA(1, 0), cA + kstep, vaC, 0); PG8_STAGE(PG8_SB(1, 1), cB + hstepB + kstep, voffB);
    PG8_WAIT_V(6); PG8_BAR;
    }
    for (;;) {
        const bool has_next = S.next(ui + 1, nxt);
        const char* nA = has_next ? S.a_ptr(nxt) : cA; const char* nB = has_next ? S.b_ptr(nxt) : cB;
        if constexpr (Sched::GATHER) { if (has_next) S.gather(ui + 1, sR, sC, vaN);
            else {
#pragma unroll
                for (int h = 0; h < 2; ++h)
#pragma unroll
                    for (int i = 0; i < 2; ++i) vaN[h][i] = vaC[h][i]; } }
        for (int t = 0; t < nt; t += 2) {
            const bool last = (t == nt - 2);
            const char* a1 = cA + (size_t)(t + 1) * kstep;
            const char* a2 = last ? nA : cA + (size_t)(t + 2) * kstep; const char* b2 = last ? nB : cB + (size_t)(t + 2) * kstep;
            const char* a3 = a2 + kstep; const char* b3 = b2 + kstep;
            if constexpr (SP2) {
            PG8_LDB(B0, 0, 0); PG8_LDB(B1, 0, 1); PG8_SCHED; PG8_LDA(At, 0, 0); PG8_STAGEA(PG8_SA(1, 1), a1, vaC, 1);
            if constexpr (Sched::GATHER) { if (last) {
#pragma unroll
                for (int h = 0; h < 2; ++h)
#pragma unroll
                    for (int i = 0; i < 2; ++i) vaC[h][i] = vaN[h][i]; } }
            PG8_WAIT_V(8); PG8_WAIT_L(0); PG8_BAR; PG8_MMA(0, 0, At, B0); PG8_MMA(0, 1, At, B1); PG8_BAR; PG8_SCHED;
            PG8_LDA(At, 0, 1); PG8_STAGE(PG8_SB(0, 0), b2, voffB); PG8_STAGE(PG8_SB(0, 1), b2 + hstepB, voffB); PG8_STAGEA(PG8_SA(0, 0), a2, vaC, 0);
            PG8_WAIT_V(8); PG8_WAIT_L(0); PG8_BAR; PG8_MMA(1, 0, At, B0); PG8_MMA(1, 1, At, B1); PG8_BAR; PG8_SCHED;
            PG8_LDB(B0, 1, 0); PG8_LDB(B1, 1, 1); PG8_SCHED; PG8_LDA(At, 1, 0); PG8_STAGEA(PG8_SA(0, 1), a2, vaC, 1);
            PG8_WAIT_V(8); PG8_WAIT_L(0); PG8_BAR; PG8_MMA(0, 0, At, B0); PG8_MMA(0, 1, At, B1); PG8_BAR; PG8_SCHED;
            PG8_LDA(At, 1, 1); PG8_STAGE(PG8_SB(1, 0), b3, voffB); PG8_STAGE(PG8_SB(1, 1), b3 + hstepB, voffB); PG8_STAGEA(PG8_SA(1, 0), a3, vaC, 0);
            PG8_WAIT_V(8); PG8_WAIT_L(0); PG8_BAR; PG8_MMA(1, 0, At, B0); PG8_MMA(1, 1, At, B1); PG8_BAR; PG8_SCHED;
            } else {
            PG8_LDB(B0, 0, 0); PG8_SCHED; PG8_LDA(At, 0, 0); PG8_STAGEA(PG8_SA(1, 1), a1, vaC, 1);
            if constexpr (Sched::GATHER) { if (last) {
#pragma unroll
                for (int h = 0; h < 2; ++h)
#pragma unroll
                    for (int i = 0; i < 2; ++i) vaC[h][i] = vaN[h][i]; } }
            PG8_WAIT_L(8); PG8_BAR; PG8_WAIT_L(0); PG8_MMA(0, 0, At, B0); PG8_BAR; PG8_SCHED;
            PG8_LDB(B1, 0, 1); PG8_STAGE(PG8_SB(0, 0), b2, voffB);
            PG8_BAR; PG8_WAIT_L(0); PG8_MMA(0, 1, At, B1); PG8_BAR;
            PG8_LDA(At, 0, 1); PG8_STAGEA(PG8_SA(0, 0), a2, vaC, 0);
            PG8_BAR; PG8_WAIT_L(0); PG8_MMA(1, 0, At, B0); PG8_BAR; PG8_SCHED;
            PG8_STAGE(PG8_SB(0, 1), b2 + hstepB, voffB);
            PG8_WAIT_V(6); PG8_BAR; PG8_MMA(1, 1, At, B1); PG8_BAR;
            PG8_LDB(B0, 1, 0); PG8_SCHED; PG8_LDA(At, 1, 0); PG8_STAGEA(PG8_SA(0, 1), a2, vaC, 1);
            PG8_WAIT_L(8); PG8_BAR; PG8_WAIT_L(0); PG8_MMA(0, 0, At, B0); PG8_BAR; PG8_SCHED;
            PG8_LDB(B1, 1, 1); PG8_STAGE(PG8_SB(1, 0), b3, voffB);
            PG8_BAR; PG8_WAIT_L(0); PG8_MMA(0, 1, At, B1); PG8_BAR;
            PG8_LDA(At, 1, 1); PG8_STAGEA(PG8_SA(1, 0), a3, vaC, 0);
            PG8_BAR; PG8_WAIT_L(0); PG8_MMA(1, 0, At, B0); PG8_BAR; PG8_SCHED;
            PG8_STAGE(PG8_SB(1, 1), b3 + hstepB, voffB);
            PG8_WAIT_V(6); PG8_BAR; PG8_MMA(1, 1, At, B1); PG8_BAR;
                    }
        }
        if (wr == 0) PG8_BAR;
        E(acc, cur, wr, wc, fr, fq);
        if (!has_next) break;
        if (!(Epi::DUAL && cur.aux == 0)) {
#pragma unroll
            for (int a = 0; a < 2; ++a)
#pragma unroll
                for (int b = 0; b < 2; ++b)
#pragma unroll
                    for (int m = 0; m < 4; ++m)
#pragma unroll
                        for (int n = 0; n < 2; ++n) acc[a][b][m][n] = (f32x4){0.f, 0.f, 0.f, 0.f};
        }
        cur = nxt; cA = nA; cB = nB; ++ui;
        if (wr == 1) PG8_BAR;
    }
    PG8_WAIT_V(0);
    PG8_BAR;
#undef PG8_SA
#undef PG8_SB
#undef PG8_STAGE
#undef PG8_STAGEA
#undef PG8_LDA
#undef PG8_LDB
#undef PG8_MMA
#undef PG8_WAIT_V
#undef PG8_WAIT_L
#undef PG8_BAR
#undef PG8_SCHED
}
}
using pg8::Unit;
typedef f32x4 AccT[2][2][4][2];

struct EpiZ {
    static constexpr bool PERM = true, DUAL = false;
    bf16_t* Z; float* ssq;
    __device__ __forceinline__ void operator()(AccT& acc, const Unit& u, int wr, int wc, int fr, int fq) const {
        const int row0 = u.pm * 256 + wr * 64 + fr, col0 = u.pn * 256 + wc * 32 + 8 * fq;
#pragma unroll
        for (int ai = 0; ai < 2; ++ai)
#pragma unroll
            for (int m = 0; m < 4; ++m) { bf16_t* rowp = Z + (size_t)(row0 + ai * 128 + m * 16) * DINP + col0;
#pragma unroll
                for (int bj = 0; bj < 2; ++bj) { if (G1_F8) { acc[ai][bj][m][0] *= F8_WINV; acc[ai][bj][m][1] *= F8_WINV; } const f32x4 v0 = acc[ai][bj][m][0], v1 = acc[ai][bj][m][1];
                    u32x4 w; w.x = cvt_pk_bf16(v0[0], v0[1]); w.y = cvt_pk_bf16(v0[2], v0[3]); w.z = cvt_pk_bf16(v1[0], v1[1]); w.w = cvt_pk_bf16(v1[2], v1[3]);
                    *(u32x4*)(rowp + bj * 128) = w; } }
        if (u.pn <= 1) {
#pragma unroll
            for (int ai = 0; ai < 2; ++ai)
#pragma unroll
                for (int m = 0; m < 4; ++m) { float s = 0.f;
#pragma unroll
                    for (int bj = 0; bj < 2; ++bj) { if (bj == 0 || u.pn == 0) {
#pragma unroll
                        for (int n = 0; n < 2; ++n) { const f32x4 v = acc[ai][bj][m][n]; s += (v[0] * v[0] + v[1] * v[1]) + (v[2] * v[2] + v[3] * v[3]); } } }
                    s += __shfl_xor(s, 16); s += __shfl_xor(s, 32);
                    if (fq == 0) ssq[((size_t)u.pn * T + row0 + ai * 128 + m * 16) * 4 + wc] = s; }
        }
    }
};
constexpr float ATT_QSC = 8.f * 0.07216878364870322f * 1.4426950408889634f;
struct EpiQ {
    static constexpr bool PERM = false, DUAL = false;
    bf16_t* Q; const float* ssq; const float* tab;
    __device__ __forceinline__ void operator()(AccT& acc, const Unit& u, int wr, int wc, int fr, int fq) const {
        const int rowb = u.pm * 256 + wr * 64 + fr;
        float rstd[8];
#pragma unroll
        for (int h = 0; h < 2; ++h) { f32x4 p[4];
#pragma unroll
            for (int m = 0; m < 4; ++m) p[m] = *(const f32x4*)(ssq + (size_t)(rowb + h * 128 + m * 16) * 4);
#pragma unroll
            for (int m = 0; m < 4; ++m) rstd[h * 4 + m] = __builtin_amdgcn_rsqf((p[m][0] + p[m][1] + p[m][2] + p[m][3]) * (1.f / 256.f) + EPS) * ATT_QSC; }
        const int d32_0 = (u.pn * 256 + wc * 32) % 192, d32_1 = (u.pn * 256 + 128 + wc * 32) % 192;
        const bool lat = u.pm < 64, rp = lat && (d32_0 >= 128 || d32_1 >= 128);
        const int rbj = d32_1 >= 128 ? 1 : 0, d32 = rbj ? d32_1 : d32_0;
        f32x4 tb[2][2];
#define EQ_LOAD(it_) do { const int npos_ = (rowb + ((it_) >> 2) * 128 + ((it_) & 3) * 16) & 8191, pos_ = (d32 == 128) ? (npos_ >> 6) : (npos_ & 63); \
            tb[(it_) & 1][0] = *(const f32x4*)(tab + (size_t)(pos_ * 16 + 4 * fq) * 2); tb[(it_) & 1][1] = *(const f32x4*)(tab + (size_t)(pos_ * 16 + 4 * fq) * 2 + 4); } while (0)
        if (rp) { EQ_LOAD(0); EQ_LOAD(1); }
#pragma unroll
        for (int it = 0; it < 8; ++it) {
            const int ai = it >> 2, m = it & 3, row = rowb + ai * 128 + m * 16;
            f32x4 t0, t1;
            if (rp) { t0 = tb[it & 1][0]; t1 = tb[it & 1][1]; if (it + 2 < 8) EQ_LOAD(it + 2); }
#pragma unroll
            for (int bj = 0; bj < 2; ++bj) {
                const int c32 = u.pn * 256 + bj * 128 + wc * 32;
                f32x4 x1 = acc[ai][bj][m][0] * rstd[it], x2 = acc[ai][bj][m][1] * rstd[it];
                if (rp && bj == rbj) {
                    const float cs[4] = {t0[0], t0[2], t1[0], t1[2]}, sn[4] = {t0[1], t0[3], t1[1], t1[3]};
                    f32x4 o1, o2;
#pragma unroll
                    for (int i = 0; i < 4; ++i) { o1[i] = x1[i] * cs[i] - x2[i] * sn[i]; o2[i] = x1[i] * sn[i] + x2[i] * cs[i]; }
                    x1 = o1; x2 = o2;
                }
                unsigned char* qp = (unsigned char*)Q + (size_t)row * NQ + c32 + 4 * fq;
                *(unsigned*)qp = pack_fp8x4_sat(x1[0], x1[1], x1[2], x1[3]); *(unsigned*)(qp + 16) = pack_fp8x4_sat(x2[0], x2[1], x2[2], x2[3]);
            }
        }
#undef EQ_LOAD
    }
};
struct EpiKV {
    static constexpr bool PERM = true, DUAL = false;
    bf16_t* KV; const float* ssq; unsigned char* K8;
    __device__ __forceinline__ void operator()(AccT& acc, const Unit& u, int wr, int wc, int fr, int fq) const {
        const int col0 = u.pn * 256 + wc * 32 + 8 * fq, rowb = u.pm * 256 + wr * 64 + fr;
        f32x4 p[8];
#pragma unroll
        for (int it = 0; it < 8; ++it) p[it] = *(const f32x4*)(ssq + (size_t)(rowb + (it >> 2) * 128 + (it & 3) * 16) * 4);
#pragma unroll
        for (int it = 0; it < 8; ++it) {
            const int ai = it >> 2, m = it & 3, row = rowb + ai * 128 + m * 16;
            const float rstd = __builtin_amdgcn_rsqf((p[it][0] + p[it][1] + p[it][2] + p[it][3]) * (1.f / 128.f) + EPS);
            { const f32x4 v0 = acc[ai][0][m][0] * rstd, v1 = acc[ai][0][m][1] * rstd;
              u32x2 w; w.x = pack_fp8x4_sat(v0[0], v0[1], v0[2], v0[3]); w.y = pack_fp8x4_sat(v1[0], v1[1], v1[2], v1[3]);
              *(u32x2*)(K8 + (size_t)row * 1024 + u.pn * 128 + wc * 32 + 8 * fq) = w; }
            { const f32x4 v0 = acc[ai][1][m][0] * rstd, v1 = acc[ai][1][m][1] * rstd;
              const int b = row < TLAT ? (row >> 13) : ((row - TLAT) >> 8), kidx = row < TLAT ? CTXL + (row & 8191) : ((row - TLAT) & 255);
              const int kap = kidx & 31, pos = (kidx & ~63) + 32 * ((kap >> 2) & 1) + (kap & 3) + 4 * (kap >> 3) + 16 * ((kidx >> 5) & 1);
              unsigned char* vt = (unsigned char*)KV + ((size_t)(b * 8 + u.pn) * 128 + wc * 32 + 8 * fq) * KTOT + pos;
              const unsigned w0 = pack_fp8x4_sat(v0[0], v0[1], v0[2], v0[3]), w1 = pack_fp8x4_sat(v1[0], v1[1], v1[2], v1[3]);
#pragma unroll
              for (int j = 0; j < 4; ++j) { vt[(size_t)j * KTOT] = (unsigned char)(w0 >> (8 * j)); vt[(size_t)(4 + j) * KTOT] = (unsigned char)(w1 >> (8 * j)); } }
        }
    }
};
struct EpiM {
    static constexpr bool PERM = true, DUAL = true;
    const bf16_t* Z; const float* bb; bf16_t* Mb;
    __device__ __forceinline__ void operator()(AccT& acc, const Unit& u, int wr, int wc, int fr, int fq) const {
        const int rowb = u.pm * 256 + wr * 64 + fr, colb = u.pn * 256 + wc * 32 + 8 * fq;
        const bf16_t* zb = Z + (size_t)rowb * DINP + colb;
        constexpr int PF = 4;
        u32x4 ra[PF], rl[PF];
        const bf16_t* zb2 = zb; (void)zb2; const int oa_ = __builtin_amdgcn_readfirstlane(u.aux ? ZC_GL : ZC_GA);
#define EM_LOAD(it_) do { const int o_ = (((it_) >> 2) & 1) * 128 * DINP + ((it_) & 3) * 16 * DINP + ((it_) >> 3) * 128; \
            ra[(it_) % PF] = *(const u32x4*)(zb + o_ + oa_); rl[(it_) % PF] = *(const u32x4*)(zb + o_ + ZC_GL); } while (0)
#pragma unroll
        for (int it = 0; it < PF; ++it) EM_LOAD(it);
        f32x4 b1a, b1b, b2a, b2b;
#pragma unroll
        for (int it = 0; it < 16; ++it) {
            const int bj = it >> 3, ai = (it >> 2) & 1, m = it & 3, col = colb + bj * 128, row = rowb + ai * 128 + m * 16;
            if ((it & 7) == 0) { b1a = *(const f32x4*)(bb + col); b1b = *(const f32x4*)(bb + col + 4); b2a = *(const f32x4*)(bb + 1024 + col); b2b = *(const f32x4*)(bb + 1024 + col + 4); }
            const u32x4 ga = ra[it % PF], gl = rl[it % PF];
            if (it + PF < 16) EM_LOAD(it + PF);
            const float x1[8] = {bf_lo(ga.x) + b1a[0], bf_hi(ga.x) + b1a[1], bf_lo(ga.y) + b1a[2], bf_hi(ga.y) + b1a[3], bf_lo(ga.z) + b1b[0], bf_hi(ga.z) + b1b[1], bf_lo(ga.w) + b1b[2], bf_hi(ga.w) + b1b[3]};
            const float x2[8] = {bf_lo(gl.x) + b2a[0], bf_hi(gl.x) + b2a[1], bf_lo(gl.y) + b2a[2], bf_hi(gl.y) + b2a[3], bf_lo(gl.z) + b2b[0], bf_hi(gl.z) + b2b[1], bf_lo(gl.w) + b2b[2], bf_hi(gl.w) + b2b[3]};
            if (u.aux == 0) {
#pragma unroll
                for (int e = 0; e < 8; ++e) { const float r = (1.f + fast_exp(-x2[e])) * __builtin_amdgcn_rcpf(1.f + fast_exp(-x1[e])); acc[ai][bj][m][e >> 2][e & 3] *= r * (MRG_F8 ? F8_SL / F8_SA : 1.f); }
            } else {
                float o[8];
#pragma unroll
                for (int e = 0; e < 8; ++e) o[e] = acc[ai][bj][m][e >> 2][e & 3] * sigmoidf_(x2[e]) * (MRG_F8 ? F8_SM * F8_WINV / F8_SL : 1.f);
#if MRG_F8
                u32x2 w; w.x = pack_fp8x4_sat(o[0], o[1], o[2], o[3]); w.y = pack_fp8x4_sat(o[4], o[5], o[6], o[7]);
                *(u32x2*)((unsigned char*)Mb + (size_t)row * D + col) = w;
#else
                u32x4 w; w.x = cvt_pk_bf16(o[0], o[1]); w.y = cvt_pk_bf16(o[2], o[3]); w.z = cvt_pk_bf16(o[4], o[5]); w.w = cvt_pk_bf16(o[6], o[7]);
                *(u32x4*)(Mb + (size_t)row * D + col) = w;
#endif
            }
        }
#undef EM_LOAD
    }
};
struct EpiX {
    static constexpr bool PERM = false, DUAL = false;
    const float* xlat; const float* xctx; const float* mod_g;
    bf16_t* X; int prev;
    __device__ __forceinline__ void operator()(AccT& acc, const Unit& u, int wr, int wc, int fr, int fq) const {
        const int bidx = u.pm < 32 ? 0 : (u.pm < 64 ? 1 : 2);
        const int rowb = u.pm * 256 + wr * 64 + fr, colb = u.pn * 256 + wc * 32 + 4 * fq;
        const float* g = mod_g + (size_t)bidx * 6144 + colb;
        const float* xi = ((u.pm < 64) ? xlat + (size_t)rowb * D : xctx + (size_t)(rowb - TLAT) * D) + colb;
        bf16_t* xo = X + (size_t)rowb * D + colb;
        f32x4 gg[4], xr[2][4];
#pragma unroll
        for (int q = 0; q < 4; ++q) gg[q] = *(const f32x4*)(g + (q >> 1) * 128 + (q & 1) * 16);
#define EX_LOAD(it_) do { _Pragma("unroll") for (int q = 0; q < 4; ++q) { const size_t o_ = (size_t)(((it_) >> 2) * 128 + ((it_) & 3) * 16) * D + (q >> 1) * 128 + (q & 1) * 16; \
            if (prev) xr[(it_) & 1][q] = bf4_to_f32x4(*(const u32x2*)(xo + o_)); else xr[(it_) & 1][q] = *(const f32x4*)(xi + o_); } } while (0)
        EX_LOAD(0);
#pragma unroll
        for (int it = 0; it < 8; ++it) {
            const int ai = it >> 2, m = it & 3;
            if (it + 1 < 8) EX_LOAD(it + 1);
#pragma unroll
            for (int q = 0; q < 4; ++q) { const f32x4 v = xr[it & 1][q] + gg[q] * (acc[ai][q >> 1][m][q & 1] * (MRG_F8 ? F8_WINV / F8_SM : 1.f));
                u32x2 w; w.x = cvt_pk_bf16(v[0], v[1]); w.y = cvt_pk_bf16(v[2], v[3]);
                *(u32x2*)(xo + (size_t)(ai * 128 + m * 16) * D + (q >> 1) * 128 + (q & 1) * 16) = w; }
        }
#undef EX_LOAD
    }
};
struct EpiACT {
    static constexpr bool PERM = true, DUAL = false;
    unsigned char* ACT; const float* bg; const float* bu;
    __device__ __forceinline__ void operator()(AccT& acc, const Unit& u, int wr, int wc, int fr, int fq) const {
        const int e = u.pn >> 3, pnl = u.pn & 7, col = pnl * 128 + wc * 32 + 8 * fq;
        const f32x4 g0 = *(const f32x4*)(bg + e * 1024 + col), g1 = *(const f32x4*)(bg + e * 1024 + col + 4), u0 = *(const f32x4*)(bu + e * 1024 + col), u1 = *(const f32x4*)(bu + e * 1024 + col + 4);
#pragma unroll
        for (int ai = 0; ai < 2; ++ai)
#pragma unroll
            for (int m = 0; m < 4; ++m) {
                const int row = u.pm * 256 + ai * 128 + wr * 64 + m * 16 + fr;
                float o[8];
#pragma unroll
                for (int k = 0; k < 8; ++k) {
                    float gv = acc[ai][0][m][k >> 2][k & 3] * F8_WINV + ((k < 4) ? g0[k & 3] : g1[k & 3]);
                    float uv = acc[ai][1][m][k >> 2][k & 3] * F8_WINV + ((k < 4) ? u0[k & 3] : u1[k & 3]);
                    gv = fminf(gv, 7.f); uv = __builtin_amdgcn_fmed3f(uv, -7.f, 7.f);
                    const float t = gv * __builtin_amdgcn_rcpf(1.f + __builtin_amdgcn_exp2f(gv * (-1.702f * LOG2E)));
                    o[k] = fmaf(t, uv, t);
                }
#if MOE2_F8
                u32x2 w; w.x = pack_fp8x4(o[0], o[1], o[2], o[3]); w.y = pack_fp8x4(o[4], o[5], o[6], o[7]);
                *(u32x2*)(ACT + (size_t)row * D + col) = w;
#else
                u32x4 w; w.x = cvt_pk_bf16(o[0], o[1]); w.y = cvt_pk_bf16(o[2], o[3]); w.z = cvt_pk_bf16(o[4], o[5]); w.w = cvt_pk_bf16(o[6], o[7]);
                *(u32x4*)((bf16_t*)ACT + (size_t)row * D + col) = w;
#endif
            }
    }
};
struct EpiY {
    static constexpr bool PERM = true, DUAL = false;
    bf16_t* Y; const float* bd; const u32x2* list;
    __device__ __forceinline__ void operator()(AccT& acc, const Unit& u, int wr, int wc, int fr, int fq) const {
        const int e = u.pn >> 2, pnl = u.pn & 3;
        const float* lw = (const float*)(list + (size_t)u.e * LCAP + u.rl * 256) + 1;
        bf16_t* yb = Y + (size_t)u.pm * 256 * D + pnl * 256;
        const float* bdp = bd + e * 1024 + pnl * 256;
        const unsigned lrow = (unsigned)opq_v(wr * 64 + fr), lcol = (unsigned)opq_v(wc * 32 + 8 * fq);
        float gwv[8]; f32x4 bv[2][2];
#pragma unroll
        for (int i = 0; i < 8; ++i) gwv[i] = lw[2 * (lrow + (i >> 2) * 128 + (i & 3) * 16)] * (MOE2_F8 ? F8_WINV : 1.f) * (Y_F8 ? 8.f : 1.f);
#pragma unroll
        for (int bj = 0; bj < 2; ++bj) { bv[bj][0] = *(const f32x4*)(bdp + lcol + bj * 128) * (MOE2_F8 ? 1.f / F8_WINV : 1.f); bv[bj][1] = *(const f32x4*)(bdp + lcol + bj * 128 + 4) * (MOE2_F8 ? 1.f / F8_WINV : 1.f); }
#pragma unroll
        for (int ai = 0; ai < 2; ++ai)
#pragma unroll
            for (int m = 0; m < 4; ++m) {
                const unsigned r = lrow + ai * 128 + m * 16;
                const float gw = gwv[ai * 4 + m];
#pragma unroll
                for (int bj = 0; bj < 2; ++bj) {
                    const unsigned c = lcol + bj * 128;
                    const f32x4 v0 = (acc[ai][bj][m][0] + bv[bj][0]) * gw, v1 = (acc[ai][bj][m][1] + bv[bj][1]) * gw;
#if Y_F8
                    { u32x2 w8; w8.x = pack_fp8x4_sat(v0[0], v0[1], v0[2], v0[3]); w8.y = pack_fp8x4_sat(v1[0], v1[1], v1[2], v1[3]);
                      *(u32x2*)((unsigned char*)Y + (size_t)u.pm * 256 * D + pnl * 256 + r * D + c) = w8; }
#else
                    u32x4 w; w.x = cvt_pk_bf16(v0[0], v0[1]); w.y = cvt_pk_bf16(v0[2], v0[3]); w.z = cvt_pk_bf16(v1[0], v1[1]); w.w = cvt_pk_bf16(v1[2], v1[3]);
                    *(u32x4*)(yb + r * D + c) = w;
#endif
                }
            }
    }
};

namespace att {
constexpr float SCALE = 0.07216878364870322f;
constexpr float THR = 2.6f;
constexpr int VPITCH = 80, SHM_V = 128 * VPITCH, KPITCH = 208, SHM_K = 64 * KPITCH, NBUF = 3, SHM_ATTN = NBUF * SHM_V + NBUF * SHM_K + 8 * 64 * 4;
#define KSWZ(row, chunk) ((row) * 384 + ((((chunk) ^ (((row) >> 1) & 7))) << 4))
#define SBAR() __builtin_amdgcn_sched_barrier(0)
__device__ __forceinline__ int crow(int r, int hi) { return (r & 3) + 8 * (r >> 2) + 4 * hi; }
__device__ __forceinline__ void partialSM(f32x16& p0, f32x16& p1, float& m_reg, float& mn, float& alpha) {
    constexpr float C = SCALE * 1.4426950408889634f;
    float pmax = p0[0];
#pragma unroll
    for (int r = 1; r < 16; ++r) pmax = fmaxf(pmax, p0[r]);
#pragma unroll
    for (int r = 0; r < 16; ++r) pmax = fmaxf(pmax, p1[r]);
    { auto rr = __builtin_amdgcn_permlane32_swap(__float_as_uint(pmax), __float_as_uint(pmax), false, false);
      pmax = fmaxf(__uint_as_float(rr[0]), __uint_as_float(rr[1])); }
    if (__builtin_expect(__all(pmax - m_reg <= THR / SCALE), 1)) { mn = m_reg; alpha = 1.f; }
    else { mn = fmaxf(m_reg, pmax); alpha = __builtin_amdgcn_exp2f((m_reg - mn) * C); m_reg = mn; }
    const float mnC = -mn * C + 5.f;
#pragma unroll
    for (int r = 0; r < 16; ++r) p0[r] = fmaf(p0[r], C, mnC);
#pragma unroll
    for (int r = 0; r < 16; ++r) p1[r] = fmaf(p1[r], C, mnC);
#pragma unroll
    for (int r = 0; r < 16; ++r) p0[r] = __builtin_amdgcn_exp2f(p0[r]);
}
__device__ __forceinline__ void finishSM(f32x16& p0, f32x16& p1, float alpha, float& l_reg, v8i& pa) {
#pragma unroll
    for (int r = 0; r < 16; ++r) p1[r] = __builtin_amdgcn_exp2f(p1[r]);
    float ps = 0;
#pragma unroll
    for (int r = 0; r < 16; ++r) ps += p0[r];
#pragma unroll
    for (int r = 0; r < 16; ++r) ps += p1[r];
    { auto rr = __builtin_amdgcn_permlane32_swap(__float_as_uint(ps), __float_as_uint(ps), false, false);
      ps = __uint_as_float(rr[0]) + __uint_as_float(rr[1]); }
    l_reg = l_reg * alpha + ps;
#pragma unroll
    for (int q = 0; q < 4; ++q) { pa[q] = (int)pack_fp8x4(p0[4 * q], p0[4 * q + 1], p0[4 * q + 2], p0[4 * q + 3]); pa[4 + q] = (int)pack_fp8x4(p1[4 * q], p1[4 * q + 1], p1[4 * q + 2], p1[4 * q + 3]); }
}
__device__ __forceinline__ void qkt(f32x16& p0, f32x16& p1, const char* Ks, const v8i* qr, int r32, int hi) {
    p0 = f32x16{}; p1 = f32x16{};
#pragma unroll
    for (int s = 0; s < 3; ++s) { const char* kp0 = Ks + r32 * KPITCH + s * 64 + hi * 32; const char* kp1 = kp0 + 32 * KPITCH;
        const v8i b0 = pg8::cat8(*reinterpret_cast<const bf16x8*>(kp0), *reinterpret_cast<const bf16x8*>(kp0 + 16));
        const v8i b1 = pg8::cat8(*reinterpret_cast<const bf16x8*>(kp1), *reinterpret_cast<const bf16x8*>(kp1 + 16));
        p0 = __builtin_amdgcn_mfma_scale_f32_32x32x64_f8f6f4(b0, qr[s], p0, 0, 0, 0, 127, 0, 127);
        p1 = __builtin_amdgcn_mfma_scale_f32_32x32x64_f8f6f4(b1, qr[s], p1, 0, 0, 0, 127, 0, 127); }
}
__device__ __forceinline__ void pv_d0(f32x16* o, const char* Vs, const v8i& pa, int r32, int hi) {
    v8i vf[4];
#pragma unroll
    for (int d0 = 0; d0 < 4; ++d0) { const char* vp = Vs + (d0 * 32 + r32) * VPITCH + hi * 32;
        vf[d0] = pg8::cat8(*reinterpret_cast<const bf16x8*>(vp), *reinterpret_cast<const bf16x8*>(vp + 16)); }
#pragma unroll
    for (int d0 = 0; d0 < 4; ++d0) o[d0] = __builtin_amdgcn_mfma_scale_f32_32x32x64_f8f6f4(pa, vf[d0], o[d0], 0, 0, 0, 127, 0, 127);
}
template <class Tick>
__device__ __forceinline__ void attn_unit(const unsigned char* __restrict__ Qb, const unsigned char* __restrict__ K8h, const unsigned char* __restrict__ Vt, const unsigned char* __restrict__ KPE, int krow_ctx, int krow_lat, int NT, int rot,
                                          bf16_t* __restrict__ Ob, char* lds, Tick& tick) {
    const int tid = opq_v(threadIdx.x), wid = tid >> 6, lane = tid & 63, r32 = lane & 31, hi = lane >> 5;
    char* V_lds = lds; char* K_lds = lds + NBUF * SHM_V;
    float* ws = (float*)(lds + NBUF * SHM_V + NBUF * SHM_K) + wid * 64; float* li_l = ws; float* al_l = ws + 32;
    float l_reg = 0; f32x16 o[4] = {}; v8i qr[3];
    const unsigned char* Qw = Qb + (size_t)(wid * 32 + r32) * NQ + hi * 32;
#pragma unroll
    for (int s3 = 0; s3 < 3; ++s3) qr[s3] = pg8::cat8(*reinterpret_cast<const bf16x8*>(Qw + s3 * 64), *reinterpret_cast<const bf16x8*>(Qw + s3 * 64 + 16));
    const unsigned voV = opq_v((tid >> 2) * KTOT + (tid & 3) * 16), voK = opq_v((tid >> 3) * 1024 + (tid & 7) * 16), voP = opq_v(((tid >> 2) & 63) * 64 + (tid & 3) * 16);
    const int lV = opq_v((tid >> 2) * VPITCH + (tid & 3) * 16), lK = opq_v((tid >> 3) * KPITCH + (tid & 7) * 16), lP = opq_v(((tid >> 2) & 63) * KPITCH + 128 + (tid & 3) * 16);
    bf16x8 vs0, ks0, kp; const bool wlo = __builtin_amdgcn_readfirstlane(tid >> 6) < 4;
#define KROW(j) (((j) < 4) ? (krow_ctx + 64 * (j)) : (krow_lat + 64 * ((j) - 4)))
#define SLOAD(j0_) do { int j_ = (j0_) + rot; j_ = j_ >= NT ? j_ - NT : j_;     \
    const int kr_ = KROW(j_); const unsigned char* vb_ = Vt + j_ * 64; const unsigned char* kb_ = K8h + (size_t)kr_ * 1024; const unsigned char* pb_ = KPE + (size_t)kr_ * 64; \
    vs0 = *reinterpret_cast<const bf16x8*>(vb_ + voV); ks0 = *reinterpret_cast<const bf16x8*>(kb_ + voK); \
    if (wlo) kp = *reinterpret_cast<const bf16x8*>(pb_ + voP); } while (0)
#define SWRITE(b) do { *(bf16x8*)(V_lds + (b) * SHM_V + lV) = vs0; *(bf16x8*)(K_lds + (b) * SHM_K + lK) = ks0; \
    if (wlo) *(bf16x8*)(K_lds + (b) * SHM_K + lP) = kp; } while (0)
#define SWAIT() asm volatile("s_waitcnt vmcnt(0)" ::: "memory")
#define RESC(a) do { if (__any((a) < 1.f)) { if (hi == 0) al_l[r32] = (a); asm volatile("s_waitcnt lgkmcnt(0)" ::: "memory"); \
    _Pragma("unroll") for (int d = 0; d < 4; ++d) _Pragma("unroll") for (int r = 0; r < 16; ++r) o[d][r] *= al_l[crow(r, hi)]; } } while (0)
#define LD32(p_) pg8::cat8(*reinterpret_cast<const bf16x8*>(p_), *reinterpret_cast<const bf16x8*>((p_) + 16))
#define MF(a_, b_, c_) __builtin_amdgcn_mfma_scale_f32_32x32x64_f8f6f4(a_, b_, c_, 0, 0, 0, 127, 0, 127)
#define MFQ(a_, b_, c_) __builtin_amdgcn_mfma_scale_f32_32x32x64_f8f6f4(a_, b_, c_, 0, 0, 0, 127, 0, 124)
#define EX4(P, i_) do { P[i_] = __builtin_amdgcn_exp2f(P[i_]); P[(i_) + 1] = __builtin_amdgcn_exp2f(P[(i_) + 1]); P[(i_) + 2] = __builtin_amdgcn_exp2f(P[(i_) + 2]); P[(i_) + 3] = __builtin_amdgcn_exp2f(P[(i_) + 3]); } while (0)
#define ROWMAX(pm_, P0, P1) do { float pm0_ = fmaxf(fmaxf(P0[0], P0[1]), P0[2]), pm1_ = fmaxf(fmaxf(P1[0], P1[1]), P1[2]); \
      _Pragma("unroll") for (int r = 3; r < 15; r += 2) { pm0_ = fmaxf(fmaxf(pm0_, P0[r]), P0[r + 1]); pm1_ = fmaxf(fmaxf(pm1_, P1[r]), P1[r + 1]); } \
      pm_ = fmaxf(fmaxf(pm0_, P0[15]), fmaxf(pm1_, P1[15])); } while (0)
#define XMAX(pm_) do { auto rr_ = __builtin_amdgcn_permlane32_swap(__float_as_uint(pm_), __float_as_uint(pm_), false, false); pm_ = fmaxf(__uint_as_float(rr_[0]), __uint_as_float(rr_[1])); } while (0)
#define VADD(d_, a_, b_) asm("v_add_f32 %0, %1, %2" : "=v"(d_) : "v"(a_), "v"(b_))
#define TAIL0() do { float sb; VADD(sa, pc0[0], pc0[1]); VADD(sb, pc0[2], pc0[3]); \
      _Pragma("unroll") for (int r = 4; r < 16; r += 2) { VADD(sa, sa, pc0[r]); VADD(sb, sb, pc0[r + 1]); } \
      VADD(sa, sa, sb); \
      _Pragma("unroll") for (int q = 0; q < 4; ++q)       \
          pa[q] = __builtin_amdgcn_cvt_pk_fp8_f32(pc0[4 * q + 2], pc0[4 * q + 3], __builtin_amdgcn_cvt_pk_fp8_f32(pc0[4 * q], pc0[4 * q + 1], pa[q], false), true); } while (0)
#define TAIL1() do { float sc, sd; VADD(sc, pc1[0], pc1[1]); VADD(sd, pc1[2], pc1[3]); \
      _Pragma("unroll") for (int r = 4; r < 16; r += 2) { VADD(sc, sc, pc1[r]); VADD(sd, sd, pc1[r + 1]); } \
      VADD(sc, sc, sd); \
      _Pragma("unroll") for (int q = 0; q < 4; ++q) \
          pa[4 + q] = __builtin_amdgcn_cvt_pk_fp8_f32(pc1[4 * q + 2], pc1[4 * q + 3], __builtin_amdgcn_cvt_pk_fp8_f32(pc1[4 * q], pc1[4 * q + 1], pa[4 + q], false), true); \
      { float ps = sa + sc; auto rr = __builtin_amdgcn_permlane32_swap(__float_as_uint(ps), __float_as_uint(ps), false, false); l_reg += __uint_as_float(rr[0]) + __uint_as_float(rr[1]); } } while (0)
#define STEP(s_) do { \
    if ((s_) + 1 < NT) { SWAIT(); SWRITE(bn); if ((s_) + 2 < NT) SLOAD((s_) + 2); } \
    { const char* Kc = K_lds + bc * SHM_K + r32 * KPITCH + hi * 32; const char* Vc = V_lds + bp * SHM_V + r32 * VPITCH + hi * 32; \
      v8i ka = LD32(Kc), kb = LD32(Kc + 32 * KPITCH), kc = LD32(Kc + 64), kd = LD32(Kc + 64 + 32 * KPITCH); \
      float sa; \
      SBAR(); TAIL0(); SBAR(); \
      pc0 = MFQ(ka, qr[0], bz); SBAR(); \
      TAIL1(); SBAR(); \
      pc1 = MFQ(kb, qr[0], bz); SBAR(); \
      ka = LD32(Kc + 128); kb = LD32(Kc + 128 + 32 * KPITCH); \
      SBAR(); pc0 = MFQ(kc, qr[1], pc0); pc1 = MFQ(kd, qr[1], pc1); SBAR(); \
      const v8i vf0 = LD32(Vc), vf1 = LD32(Vc + 32 * VPITCH), vf2 = LD32(Vc + 64 * VPITCH), vf3 = LD32(Vc + 96 * VPITCH); \
      SBAR(); pc0 = MFQ(ka, qr[2], pc0); pc1 = MFQ(kb, qr[2], pc1); SBAR(); \
      o[0] = MF(pa, vf0, o[0]); SBAR(); \
      float pm; ROWMAX(pm, pc0, pc1); \
      SBAR(); o[1] = MF(pa, vf1, o[1]); SBAR(); \
      asm volatile("" : "+v"(o[0]), "+v"(o[1]));     \
      XMAX(pm); \
      float al_ = 1.f; \
      if (__builtin_expect(__any(pm > LIM), 0)) {          \
          const float dl = fmaxf(pm - 5.f, 0.f); \
          _Pragma("unroll") for (int r = 0; r < 16; ++r) { pc0[r] -= dl; pc1[r] -= dl; } \
          { const float nb_ = bz[0] - dl; _Pragma("unroll") for (int r = 0; r < 16; ++r) bz[r] = nb_; } \
          al_ = __builtin_amdgcn_exp2f(-dl); l_reg *= al_; \
      } \
      SBAR(); o[2] = MF(pa, vf2, o[2]); SBAR(); \
      EX4(pc0, 0); EX4(pc0, 4); EX4(pc0, 8); EX4(pc0, 12); \
      SBAR(); o[3] = MF(pa, vf3, o[3]); SBAR(); \
      EX4(pc1, 0); EX4(pc1, 4); EX4(pc1, 8); EX4(pc1, 12); \
      asm volatile("" : "+v"(pc0), "+v"(pc1));     \
      RESC(al_); \
    } \
    __syncthreads(); \
    { const int t_ = bp; bp = bc; bc = bn; bn = t_; } } while (0)
    if (wid >= 4) __builtin_amdgcn_s_setprio(1);
    f32x16 pc0, pc1; v8i pa = {};
    constexpr float LIM = 5.f + THR * 1.4426950408889634f;
    f32x16 bz = {};
    int bp = 0, bc = 1, bn = 2;
    __syncthreads();
    SLOAD(0); SWAIT(); SWRITE(0); SLOAD(1); SWAIT(); SWRITE(1); if (2 < NT) SLOAD(2);
    __syncthreads();
    {
        const char* Kc = K_lds + r32 * KPITCH + hi * 32;
        pc0 = f32x16{}; pc1 = f32x16{};
#pragma unroll
        for (int s3 = 0; s3 < 3; ++s3) { const v8i ka = LD32(Kc + 64 * s3), kb = LD32(Kc + 64 * s3 + 32 * KPITCH); pc0 = MFQ(ka, qr[s3], pc0); pc1 = MFQ(kb, qr[s3], pc1); }
        float pm; ROWMAX(pm, pc0, pc1); XMAX(pm);
        const float dl = pm - 5.f;
#pragma unroll
        for (int r = 0; r < 16; ++r) { pc0[r] -= dl; pc1[r] -= dl; }
#pragma unroll
        for (int r = 0; r < 16; ++r) bz[r] = -dl;
        EX4(pc0, 0); EX4(pc0, 4); EX4(pc0, 8); EX4(pc0, 12); EX4(pc1, 0); EX4(pc1, 4); EX4(pc1, 8); EX4(pc1, 12);
    }
    for (int s = 1; s + 1 < NT; s += 2) {
        STEP(s);
        STEP(s + 1);
    }
    STEP(NT - 1);
    { float sa; TAIL0(); TAIL1(); }
    SBAR();
    pv_d0(o, V_lds + bp * SHM_V, pa, r32, hi);
    __builtin_amdgcn_s_setprio(0);
    if (hi == 0) li_l[r32] = l_reg; asm volatile("s_waitcnt lgkmcnt(0)" ::: "memory");
    float rli[16];
#pragma unroll
    for (int r = 0; r < 16; ++r) rli[r] = __builtin_amdgcn_rcpf(li_l[crow(r, hi)]);
    bf16_t* Ow = Ob + (size_t)(wid * 32) * 2048;
#pragma unroll
    for (int r = 0; r < 16; ++r) { const int orow = crow(r, hi);
#pragma unroll
        for (int d0 = 0; d0 < 4; ++d0) {
#if MRG_F8
            ((unsigned char*)Ob)[(size_t)(wid * 32 + orow) * 2048 + d0 * 32 + r32] = (unsigned char)(pack_fp8x4_sat(o[d0][r] * rli[r] * F8_SA, 0.f, 0.f, 0.f) & 0xffu);
#else
            Ow[(size_t)orow * 2048 + d0 * 32 + r32] = (bf16_t)(cvt_pk_bf16(o[d0][r] * rli[r], 0.f) & 0xffffu);
#endif
        } }
#undef STEP
#undef TAIL0
#undef TAIL1
#undef VADD
#undef LD32
#undef MF
#undef MFQ
#undef EX4
#undef ROWMAX
#undef XMAX
#undef KROW
#undef SLOAD
#undef SWRITE
#undef SWAIT
#undef RESC
}
}

struct Args { const float* in[33]; float* out; unsigned char* ws; int ph_lo, ph_hi; };
struct Ctx {
    unsigned char* lds; unsigned char* ws; int tid, lane, wave, G;
    InArr in;
};
__device__ __forceinline__ Ctx fresh(const Ctx& C0) {
    Ctx C; C.lds = C0.lds; C.ws = opq(C0.ws); C.in = opq_in(C0.in); C.G = C0.G; C.tid = opq_v(threadIdx.x); C.lane = C.tid & 63; C.wave = __builtin_amdgcn_readfirstlane(C.tid >> 6); return C;
}
enum { I_X = 0, I_C, I_CTX, I_CCTX, I_WADA, I_BADA, I_NMIX, I_NFFN, I_WIN, I_BBG, I_QN, I_WUQ, I_KVN, I_WUKV, I_WOA, I_CONVW, I_CONVB, I_LWA, I_LBA, I_LWX, I_LBX, I_LAM, I_WOL, I_WOUT, I_WR, I_BR,
       I_WEG, I_BEG, I_WEU, I_BEU, I_WED, I_BED, I_FN };

__device__ __forceinline__ void phase_adaln(const Ctx& C0, const Args& a) {
    const Ctx C = fresh(C0); unsigned char* ws = C.ws; InArr in = C.in; (void)ws; (void)in;
    LAS float* SC = (LAS float*)(C.lds);
    LAS float* RED = (LAS float*)(C.lds + 16384);
    float* MOD = (float*)(ws + WS_MOD);
    const int b = blockIdx.x;
    if (b < 192) {
        for (int i = C.tid; i < 3072; i += 512) { const int r = i >> 10, k = i & 1023; const float v = r < 2 ? inp(in, I_C)[r * 1024 + k] : inp(in, I_CCTX)[k]; SC[i] = v * sigmoidf_(v); }
        __syncthreads();
        for (int item = b; item < 192; item += C.G) {
            const int l = item / 96, cg = item % 96, col = cg * 64 + C.lane;
            const float* W = inp(in, I_WADA) + (size_t)l * 1024 * 6144 + col;
            float a0 = 0.f, a1 = 0.f, a2 = 0.f; const int k0 = C.wave * 128;
#pragma unroll 1
            for (int kb = 0; kb < 128; kb += 64) { float w[64];
#pragma unroll
                for (int i = 0; i < 64; ++i) w[i] = __builtin_nontemporal_load(W + (size_t)(k0 + kb + i) * 6144);
#pragma unroll
                for (int i = 0; i < 64; ++i) { a0 += SC[k0 + kb + i] * w[i]; a1 += SC[1024 + k0 + kb + i] * w[i]; a2 += SC[2048 + k0 + kb + i] * w[i]; } }
            RED[(C.wave * 3 + 0) * 64 + C.lane] = a0; RED[(C.wave * 3 + 1) * 64 + C.lane] = a1; RED[(C.wave * 3 + 2) * 64 + C.lane] = a2;
            __syncthreads();
            if (C.wave == 0) {
#pragma unroll
                for (int r = 0; r < 3; ++r) { float s = 0.f;
#pragma unroll
                    for (int w = 0; w < 8; ++w) s += RED[(w * 3 + r) * 64 + C.lane];
                    MOD[(size_t)(l * 3 + r) * 6144 + col] = s + inp(in, I_BADA)[l * 6144 + col]; }
            }
            __syncthreads();
        }
    }
    if (b == C.G - 1) {
        float* TAB = (float*)(ws + WS_TAB); float* LC = (float*)(ws + WS_LRUC);
        for (int i = C.tid; i < 2048; i += 512) { const int pos = i >> 4, j = i & 15;
            const float inv = __builtin_amdgcn_exp2f(-(float)j * (13.287712379549449f / 16.f));
            const float ang = (float)pos * inv; TAB[2 * i] = __cosf(ang); TAB[2 * i + 1] = __sinf(ang); }
        for (int i = C.tid; i < 4096; i += 512) { const float y = -inp(in, I_LAM)[i]; LC[i] = 8.f * (fmaxf(y, 0.f) + log1pf(expf(-fabsf(y)))); }
    }
}

__device__ __forceinline__ void build_mod_tables(const Ctx& C0, const Args& a, int l, int which, LAS float* GS, LAS float* SH) {
    const Ctx C = fresh(C0); unsigned char* ws = C.ws; InArr in = C.in; (void)ws; (void)in;
    const float* MOD = (const float*)(ws + WS_MOD); const float* gain = inp(in, which ? I_NFFN : I_NMIX) + l * 1024;
    for (int i = C.tid; i < 3072; i += 512) { const int r = i >> 10, k = i & 1023; const float* m = MOD + (size_t)(l * 3 + r) * 6144 + (which ? 3072 : 0);
        GS[i] = gain[k] * (1.f + m[1024 + k]); SH[i] = m[k]; }
}
__device__ __forceinline__ void norm_store_bf16(const f32x4 (&v)[4], const LAS float* gs, const LAS float* sh, bf16_t* orow, int lane) {
    float s = 0.f;
#pragma unroll
    for (int j = 0; j < 4; ++j) s += (v[j][0] * v[j][0] + v[j][1] * v[j][1]) + (v[j][2] * v[j][2] + v[j][3] * v[j][3]);
    const float rstd = __builtin_amdgcn_rsqf(wave_sum(s) * (1.f / 1024.f) + EPS);
#pragma unroll
    for (int j = 0; j < 4; ++j) { const int c = 4 * lane + 256 * j; const f32x4 g = *(const LAS f32x4*)(gs + c), h = *(const LAS f32x4*)(sh + c);
        const f32x4 y = v[j] * rstd * g + h;
#if G1_F8
        *(unsigned*)((unsigned char*)orow + c) = pack_fp8x4_sat(y[0], y[1], y[2], y[3]);
#else
        u32x2 w; w.x = cvt_pk_bf16(y[0], y[1]); w.y = cvt_pk_bf16(y[2], y[3]); *(u32x2*)(orow + c) = w;
#endif
    }
}

struct CvtDesc { const float* src; int K, N, Ndst; bf16_t* dst; int ldd, mode; const float* gain; int kt, nt, f8; };
__device__ __forceinline__ void cvt_load(const CvtDesc& d, int tid, f32x4 (&R)[8]) {
    const int k0 = d.kt * 128, n0 = d.nt * 128;
#pragma unroll
    for (int i = 0; i < 8; ++i) { const int idx = tid + 512 * i, gk = k0 + (idx >> 5), gn = n0 + (idx & 31) * 4;
        R[i] = (f32x4){0.f, 0.f, 0.f, 0.f};
        if (gk < d.K && gn < d.N) { R[i] = __builtin_nontemporal_load((const f32x4*)(d.src + (size_t)gk * d.N + gn)); if (d.gain) R[i] = R[i] * d.gain[gk]; } }
}
__device__ __forceinline__ void cvt_to_lds(const CvtDesc& d, LAS bf16_t* Tl, int tid, const f32x4 (&R)[8]) {
    if (d.f8) { LAS unsigned char* T8 = (LAS unsigned char*)Tl;
#pragma unroll
        for (int i = 0; i < 8; ++i) { const int idx = tid + 512 * i, k = idx >> 5, n4 = (idx & 31) * 4;
            *(LAS unsigned*)(T8 + k * 132 + (n4 ^ (4 * (k >> 4)))) = pack_fp8x4(R[i][0] * F8_WSCALE, R[i][1] * F8_WSCALE, R[i][2] * F8_WSCALE, R[i][3] * F8_WSCALE); }
    } else {
#pragma unroll
        for (int i = 0; i < 8; ++i) { const int idx = tid + 512 * i, k = idx >> 5, n4 = (idx & 31) * 4;
            u32x2 w; w.x = cvt_pk_bf16(R[i][0], R[i][1]); w.y = cvt_pk_bf16(R[i][2], R[i][3]); *(LAS u32x2*)(Tl + k * 132 + n4) = w; }
    }
}
__device__ __forceinline__ void cvt_store(const CvtDesc& d, LAS bf16_t* Tl, int tid) {
    const int k0 = d.kt * 128, n0 = d.nt * 128;
    const int drow0 = d.mode == 0 ? n0 : ((n0 >> 7) * 256 + (d.mode - 1) * 128);
    if (d.f8) { const LAS unsigned char* T8 = (const LAS unsigned char*)Tl; unsigned char* dst8 = (unsigned char*)d.dst;
#pragma unroll
        for (int p = 0; p < 2; ++p) { const int q = tid + 512 * p, nl = q >> 3, k16 = (q & 7) * 16, nsw = nl ^ (4 * (q & 7));
            unsigned w[4], bb[16];
#pragma unroll
            for (int i = 0; i < 16; ++i) bb[i] = T8[(k16 + i) * 132 + nsw];
            __builtin_amdgcn_sched_barrier(0);
#pragma unroll
            for (int j = 0; j < 4; ++j) w[j] = bb[4 * j] | (bb[4 * j + 1] << 8) | (bb[4 * j + 2] << 16) | (bb[4 * j + 3] << 24);
            *(u32x4*)(dst8 + (size_t)(drow0 + nl) * d.ldd + k0 + k16) = (u32x4){w[0], w[1], w[2], w[3]}; }
        return; }
#pragma unroll
    for (int p = 0; p < 4; ++p) { const int nl = (tid & 31) + 32 * p, k8 = ((tid >> 5) & 15) * 8;
        if (n0 + nl < d.Ndst && k0 + k8 < d.K) {
            unsigned short e[8];
#pragma unroll
            for (int i = 0; i < 8; ++i) e[i] = Tl[(k8 + i) * 132 + nl];
            u32x4 w; w.x = e[0] | ((unsigned)e[1] << 16); w.y = e[2] | ((unsigned)e[3] << 16); w.z = e[4] | ((unsigned)e[5] << 16); w.w = e[6] | ((unsigned)e[7] << 16);
            *(u32x4*)(d.dst + (size_t)(drow0 + nl) * d.ldd + k0 + k8) = w; } }
}
constexpr int CV_WIN = 8 * 36, CV_WUQ = 2 * 12, CV_WUKV = 16, CV_SQ = 64, CV_WR = 8, CV_LW = 64, CV_EXP = 32 * 64;
constexpr int CV_SMALL = CV_WIN + CV_WUQ + CV_WUKV + 3 * CV_SQ + CV_WR + CV_LW;
constexpr int CV_LAYER = CV_SMALL + 3 * CV_EXP, CV_TOTAL = 2 * CV_LAYER;
__device__ __forceinline__ CvtDesc cvt_decode(unsigned char* ws, InArr in, int item) {
    const int l = item / CV_LAYER; int r = item % CV_LAYER;
    unsigned char* wl = ws + WS_WL + (size_t)l * WL_STRIDE;
    CvtDesc d; d.gain = nullptr; d.mode = 0; d.f8 = 0;
    if (r < CV_WIN) { d.src = inp(in, I_WIN) + (size_t)l * 1024 * DIN; d.K = 1024; d.N = DIN; d.Ndst = DINP; d.dst = (bf16_t*)(wl + OFF_WIN); d.ldd = 1024; d.f8 = G1_F8; d.kt = r / 36; d.nt = r % 36; return d; } r -= CV_WIN;
    if (r < CV_WUQ) { d.src = inp(in, I_WUQ) + (size_t)l * 256 * NQ; d.K = 256; d.N = NQ; d.Ndst = NQ; d.dst = (bf16_t*)(wl + OFF_WUQ); d.ldd = 256; d.gain = inp(in, I_QN) + l * 256; d.kt = r / 12; d.nt = r % 12; return d; } r -= CV_WUQ;
    if (r < CV_WUKV) { d.src = inp(in, I_WUKV) + (size_t)l * 128 * NKV; d.K = 128; d.N = NKV; d.Ndst = NKV; d.dst = (bf16_t*)(wl + OFF_WUKV); d.ldd = 128; d.gain = inp(in, I_KVN) + l * 128; d.kt = 0; d.nt = r; return d; } r -= CV_WUKV;
    if (r < CV_SQ) { d.src = inp(in, I_WOA) + (size_t)l * D * D; d.K = D; d.N = D; d.Ndst = D; d.dst = (bf16_t*)(wl + OFF_WM); d.ldd = 2048; d.f8 = MRG_F8; d.kt = r >> 3; d.nt = r & 7; return d; } r -= CV_SQ;
    if (r < CV_SQ) { d.src = inp(in, I_WOL) + (size_t)l * D * D; d.K = D; d.N = D; d.Ndst = D; d.dst = (bf16_t*)(wl + OFF_WM + (MRG_F8 ? 1024 : 2048)); d.ldd = 2048; d.f8 = MRG_F8; d.kt = r >> 3; d.nt = r & 7; return d; } r -= CV_SQ;
    if (r < CV_SQ) { d.src = inp(in, I_WOUT) + (size_t)l * D * D; d.K = D; d.N = D; d.Ndst = D; d.dst = (bf16_t*)(wl + OFF_WOUT); d.ldd = 1024; d.f8 = MRG_F8; d.kt = r >> 3; d.nt = r & 7; return d; } r -= CV_SQ;
    if (r < CV_WR) { d.src = inp(in, I_WR) + (size_t)l * D * NE; d.K = D; d.N = NE; d.Ndst = NE; d.dst = (bf16_t*)(wl + OFF_WR); d.ldd = 1024; d.kt = r; d.nt = 0; return d; } r -= CV_WR;
    if (r < CV_LW) { const int g = r & 1, dn = r >> 1, dd = dn >> 4, nb = dn & 15;
        d.src = inp(in, g ? I_LWX : I_LWA) + ((size_t)(l * 2 + dd) * 16 + nb) * 4096; d.K = 64; d.N = 64; d.Ndst = 64; d.dst = (bf16_t*)(wl + OFF_LW) + ((size_t)nb * 4 + 2 * dd + g) * 4096; d.ldd = 64; d.kt = 0; d.nt = 0; return d; } r -= CV_LW;
    const int which = r / CV_EXP; r %= CV_EXP; const int e = r >> 6, t = r & 63;
    d.K = D; d.N = D; d.Ndst = D; d.kt = t >> 3; d.nt = t & 7; d.ldd = 1024;
    d.f8 = 1;
    if (which == 0) { d.src = inp(in, I_WEG) + ((size_t)l * NE + e) * D * D; d.dst = (bf16_t*)(ws + WS_WGU + (size_t)l * WGU_STRIDE + (size_t)e * 2048 * 1024); d.mode = 1; }
    else if (which == 1) { d.src = inp(in, I_WEU) + ((size_t)l * NE + e) * D * D; d.dst = (bf16_t*)(ws + WS_WGU + (size_t)l * WGU_STRIDE + (size_t)e * 2048 * 1024); d.mode = 2; }
    else { d.src = inp(in, I_WED) + ((size_t)l * NE + e) * D * D; d.f8 = MOE2_F8; d.dst = (bf16_t*)(ws + WS_WD + (size_t)l * WD_STRIDE + (size_t)e * 1024 * 1024 * (MOE2_F8 ? 1 : 2)); }
    return d;
}
static_assert(MOE2_F8 == 1, "the engine writes e4m3 for all three expert matrices");
struct CvtEngine {
    unsigned char* ws; InArr in; LAS unsigned char* T8; int l, nxt, end, vR, vL; f32x4 R[4];
    unsigned char* dstR; unsigned char* dstL;
    __device__ __forceinline__ void issue() {
        vR = nxt < end;
        if (vR) {
            const int tid = opq_v(threadIdx.x);
            const int r = nxt >> 1, half = nxt & 1, which = r >> 11, rr = r & 2047, e = rr >> 6, t = rr & 63, kt = t >> 3, nt = t & 7, k0 = kt * 128 + half * 64;
            const float* src = inp(in, which == 0 ? I_WEG : which == 1 ? I_WEU : I_WED) + ((size_t)l * NE + e) * D * D + (size_t)k0 * 1024 + nt * 128;
            dstR = which < 2 ? ws + WS_WGU + (size_t)l * WGU_STRIDE + (size_t)e * 2048 * 1024 + (size_t)(nt * 256 + which * 128) * 1024 + k0
                             : ws + WS_WD + (size_t)l * WD_STRIDE + (size_t)e * 1024 * 1024 + (size_t)(nt * 128) * 1024 + k0;
            src = opq(src);
#pragma unroll
            for (int i = 0; i < 4; ++i) { const int idx = tid + 512 * i; R[i] = __builtin_nontemporal_load((const f32x4*)(src + (unsigned)((idx >> 5) * 1024 + (idx & 31) * 4))); }
            nxt += 256;
        }
    }
    __device__ __forceinline__ void A() {
        vL = vR; dstL = dstR;
        if (vR) {
            const int tid = opq_v(threadIdx.x);
#pragma unroll
            for (int i = 0; i < 4; ++i) { const int idx = tid + 512 * i, k = idx >> 5, n4 = (idx & 31) * 4;
                *(LAS unsigned*)(T8 + k * 132 + (n4 ^ (4 * (k >> 4)))) = pack_fp8x4(R[i][0] * F8_WSCALE, R[i][1] * F8_WSCALE, R[i][2] * F8_WSCALE, R[i][3] * F8_WSCALE); }
        }
        issue();
    }
    __device__ __forceinline__ void B() {
        if (vL) {
            const int q = opq_v(threadIdx.x), nl = q >> 2, k16 = (q & 3) * 16, nsw = nl ^ (4 * (q & 3));
            unsigned w[4], bb[16];
#pragma unroll
            for (int i = 0; i < 16; ++i) bb[i] = T8[(k16 + i) * 132 + nsw];
            __builtin_amdgcn_sched_barrier(0);
#pragma unroll
            for (int j = 0; j < 4; ++j) w[j] = bb[4 * j] | (bb[4 * j + 1] << 8) | (bb[4 * j + 2] << 16) | (bb[4 * j + 3] << 24);
            *(u32x4*)(dstL + (unsigned)(nl * 1024 + k16)) = (u32x4){w[0], w[1], w[2], w[3]};
        }
        vL = 0;
    }
};
struct NoTick { __device__ __forceinline__ void step() {} };
constexpr int ATT_CVT_OFF = 73728;
constexpr int ENG_H1 = 16, ENG_H2 = 32;
constexpr int ENG_ITEMS = 3 * CV_EXP;
__device__ __forceinline__ void phase_prologue(const Ctx& C0, const Args& a) {
    const Ctx C = fresh(C0); unsigned char* ws = C.ws; InArr in = C.in; (void)ws; (void)in;
    LAS float* GS = (LAS float*)(C.lds + 65536); LAS float* SH = GS + 3072;
    build_mod_tables(C, a, 0, 0, GS, SH);
    __syncthreads();
    bf16_t* H = (bf16_t*)(ws + WS_H);
    for (int row = blockIdx.x * 8 + C.wave; row < T; row += C.G * 8) {
        const float* xr = row < TLAT ? inp(in, I_X) + (size_t)row * D : inp(in, I_CTX) + (size_t)(row - TLAT) * D;
        const int r = row < TLAT ? (row >> 13) : 2;
        f32x4 v[4];
#pragma unroll
        for (int j = 0; j < 4; ++j) v[j] = *(const f32x4*)(xr + 4 * C.lane + 256 * j);
        norm_store_bf16(v, GS + r * 1024, SH + r * 1024, H + (size_t)row * (G1_F8 ? D / 2 : D), C.lane);
    }
    __syncthreads();
    {
        LAS bf16_t* Tl = (LAS bf16_t*)(C.lds);
        const int eng = (opq_i(C.G) == 256) ? ENG_ITEMS : 0, per = CV_LAYER - eng; const int NSM = 2 * per;
#define SMALL_ITEM(i_) (((i_) / per) * CV_LAYER + (((i_) % per) < CV_SMALL ? ((i_) % per) : ((i_) % per) + eng))
        int it = blockIdx.x; CvtDesc d, dn; f32x4 R[8];
        if (it < NSM) { d = cvt_decode(ws, in, SMALL_ITEM(it)); cvt_load(d, C.tid, R); }
#pragma unroll 1
        for (; it < NSM; it += C.G) {
            cvt_to_lds(d, Tl, C.tid, R);
            __syncthreads();
            const int nxt = it + C.G;
            if (nxt < NSM) { dn = cvt_decode(ws, in, SMALL_ITEM(nxt)); cvt_load(dn, C.tid, R); }
            cvt_store(d, Tl, C.tid);
            __syncthreads();
            d = dn;
        }
#undef SMALL_ITEM
    }
}
__device__ __forceinline__ void kpe_rope(const Ctx& C0) {
    const Ctx C = fresh(C0); unsigned char* ws = C.ws; InArr in = C.in; (void)ws; (void)in;
    const bf16_t* Z = (const bf16_t*)(ws + WS_Z); bf16_t* KPE = (bf16_t*)(ws + WS_KPE); const float* TAB = (const float*)(ws + WS_TAB);
    constexpr int NI = (T * 32 + 256 * 512 - 1) / (256 * 512);
    const int i0 = blockIdx.x * 512 + C.tid, st = C.G * 512;
    if (C.G == 256) {
        bf16_t z1[NI], z2[NI]; float cs[NI], sn[NI];
#pragma unroll
        for (int q = 0; q < NI; ++q) { const int i = i0 + q * st; z1[q] = 0; z2[q] = 0; cs[q] = 1.f; sn[q] = 0.f;
            if (i < T * 32) { const int row = i >> 5, p = i & 31, aa = p >> 4, j = p & 15;
                z1[q] = Z[(size_t)row * DINP + ZC_KPE + aa * 32 + j]; z2[q] = Z[(size_t)row * DINP + ZC_KPE + aa * 32 + 16 + j];
                if (row < TLAT) { const int npos = row & 8191, pos = aa == 0 ? (npos >> 6) : (npos & 63); cs[q] = TAB[(pos * 16 + j) * 2]; sn[q] = TAB[(pos * 16 + j) * 2 + 1]; } } }
#pragma unroll
        for (int q = 0; q < NI; ++q) { const int i = i0 + q * st;
            if (i < T * 32) { const int row = i >> 5, p = i & 31, aa = p >> 4, j = p & 15;
                float x1 = bf1(z1[q]), x2 = bf1(z2[q]);
                if (row < TLAT) { const float o1 = x1 * cs[q] - x2 * sn[q], o2 = x1 * sn[q] + x2 * cs[q]; x1 = o1; x2 = o2; }
                const unsigned pk = pack_fp8x4_sat(x1, x2, 0.f, 0.f);
                ((unsigned char*)KPE)[(size_t)row * 64 + aa * 32 + j] = (unsigned char)(pk & 0xffu); ((unsigned char*)KPE)[(size_t)row * 64 + aa * 32 + 16 + j] = (unsigned char)((pk >> 8) & 0xffu); } }
        return;
    }
    for (int i = i0; i < T * 32; i += st) {
        const int row = i >> 5, p = i & 31, aa = p >> 4, j = p & 15;
        float x1 = bf1(Z[(size_t)row * DINP + ZC_KPE + aa * 32 + j]), x2 = bf1(Z[(size_t)row * DINP + ZC_KPE + aa * 32 + 16 + j]);
        if (row < TLAT) { const int npos = row & 8191, pos = aa == 0 ? (npos >> 6) : (npos & 63); const float cs = TAB[(pos * 16 + j) * 2], sn = TAB[(pos * 16 + j) * 2 + 1];
            const float o1 = x1 * cs - x2 * sn, o2 = x1 * sn + x2 * cs; x1 = o1; x2 = o2; }
        const unsigned pk = pack_fp8x4_sat(x1, x2, 0.f, 0.f);
        ((unsigned char*)KPE)[(size_t)row * 64 + aa * 32 + j] = (unsigned char)(pk & 0xffu); ((unsigned char*)KPE)[(size_t)row * 64 + aa * 32 + 16 + j] = (unsigned char)((pk >> 8) & 0xffu);
    }
}

constexpr int LR_LW = 0, LR_XLB = 36864, LR_XLF = 46080, LR_AU = 63488, LR_SEG = 133120, LR_CAR = 137216, LR_CVT = 145920, LR_P = 68;
__device__ __forceinline__ void lru_load_weights(const Ctx& C0, int l, int nb) {
    const Ctx C = fresh(C0); unsigned char* ws = C.ws; InArr in = C.in; (void)ws; (void)in;
    const bf16_t* LW = (const bf16_t*)(ws + WS_WL + (size_t)l * WL_STRIDE + OFF_LW) + (size_t)nb * 4 * 4096;
    u32x4 w[4];
#pragma unroll
    for (int j = 0; j < 4; ++j) { const int i = C.tid + 512 * j, row = i >> 3, c8 = (i & 7) * 8; w[j] = *(const u32x4*)(LW + row * 64 + c8); }
#pragma unroll
    for (int j = 0; j < 4; ++j) { const int i = C.tid + 512 * j, row = i >> 3, c8 = (i & 7) * 8; *(LAS u32x4*)(C.lds + LR_LW + (row * 72 + c8) * 2) = w[j]; }
}
__device__ __forceinline__ int carry_chunk(int b, int dir, int p) {
    return dir == 0 ? (p < 4 ? 256 + 4 * b + p : 128 * b + (p - 4)) : (p < 4 ? 256 + 4 * b + 3 - p : 128 * b + 127 - (p - 4));
}
__device__ __forceinline__ void lru_load_x(const bf16_t* Z, int cidx, int nb, int tid, u32x4 (&xv)[4]) {
    const int row0 = cidx * 64, seq0 = row0 < TLAT ? (row0 & ~8191) : (row0 & ~255), seqL = row0 < TLAT ? SEQ : CTXL;
    const int t = tid >> 3, ch = nb * 64 + (tid & 7) * 8, n = row0 + t - seq0;
#pragma unroll
    for (int k = 0; k < 4; ++k) { const int nn = n + k - 2; xv[k] = (u32x4){0u, 0u, 0u, 0u};
        if (nn >= 0 && nn < seqL) xv[k] = *(const u32x4*)(Z + (size_t)(seq0 + nn) * DINP + ZC_XR + ch); }
}
template <int PASS>
__device__ __forceinline__ void lru_pass(const Ctx& C0, const Args& a, int l) {
    const Ctx C = fresh(C0); unsigned char* ws = C.ws; InArr in = C.in;
    const int nb = blockIdx.x & 15, cstep = C.G >> 4;
    CvtEngine E; E.ws = ws; E.in = in; E.T8 = (LAS unsigned char*)(C.lds + LR_CVT); E.l = l; E.vR = 0; E.vL = 0; E.dstR = ws; E.dstL = ws;
#pragma unroll
    for (int i = 0; i < 4; ++i) E.R[i] = (f32x4){0.f, 0.f, 0.f, 0.f};
    { const int b = __builtin_amdgcn_readfirstlane((int)blockIdx.x);
      E.nxt = b + 256 * (PASS == 1 ? 0 : ENG_H1); E.end = (opq_i(C.G) == 256) ? 256 * (PASS == 1 ? ENG_H1 : ENG_H1 + ENG_H2) : 0; }
    E.issue();
    const bf16_t* Z = (const bf16_t*)(ws + WS_Z);
    LAS bf16_t* XLB = (LAS bf16_t*)(C.lds + LR_XLB); LAS float* XLF = (LAS float*)(C.lds + LR_XLF); LAS float* AU = (LAS float*)(C.lds + LR_AU);
    LAS f32x2* SEG = (LAS f32x2*)(C.lds + LR_SEG);
    __syncthreads();
    lru_load_weights(C, l, nb);
    const int ct_t = C.tid >> 3, c8 = (C.tid & 7) * 8, fr = C.lane & 15, fq = C.lane >> 4;
    float cw[4][8], cb[8];
    { const float* cbp = inp(in, I_CONVB) + l * 1024 + nb * 64 + c8;
#pragma unroll
      for (int i = 0; i < 8; ++i) cb[i] = cbp[i];
#pragma unroll
      for (int k = 0; k < 4; ++k) { const float* w = inp(in, I_CONVW) + (size_t)(l * 4 + k) * 1024 + nb * 64 + c8;
#pragma unroll
          for (int i = 0; i < 8; ++i) cw[k][i] = w[i]; } }
    float gba[2][2], gbx[2][2], gcc[2][2];
    { const float* LC = (const float*)(ws + WS_LRUC) + (size_t)l * 2048;
#pragma unroll
      for (int s2 = 0; s2 < 2; ++s2) { const int ch = nb * 64 + ((C.wave * 2 + s2) & 3) * 16 + fr;
#pragma unroll
          for (int dd = 0; dd < 2; ++dd) { gba[s2][dd] = -LOG2E * inp(in, I_LBA)[(l * 2 + dd) * 1024 + ch]; gbx[s2][dd] = -LOG2E * inp(in, I_LBX)[(l * 2 + dd) * 1024 + ch]; gcc[s2][dd] = -LOG2E * LC[dd * 1024 + ch]; } } }
    const int dir = C.tid >> 8, seg = (C.tid >> 6) & 3, chl = C.tid & 63;
    LAS float* CARL = (LAS float*)(C.lds + LR_CAR);
    if (PASS == 2) {
        if (C.tid < 256) { const int cd = C.tid >> 7, cb = (C.tid >> 6) & 1, ch = nb * 64 + (C.tid & 63), c0 = blockIdx.x >> 4;
            const f32x2* SUM = (const f32x2*)(ws + WS_SUM); float S = 0.f;
#pragma unroll 1
            for (int p0 = 0; p0 < 132; p0 += 33) { f32x2 v[33];
#pragma unroll
                for (int i = 0; i < 33; ++i) v[i] = SUM[((size_t)carry_chunk(cb, cd, p0 + i) * 2 + cd) * 1024 + ch];
#pragma unroll
                for (int i = 0; i < 33; ++i) { const int c = carry_chunk(cb, cd, p0 + i); if ((c - c0) % cstep == 0) CARL[(((c - c0) / cstep) * 2 + cd) * 64 + (C.tid & 63)] = S; S = v[i][0] * S + v[i][1]; } } }
        __syncthreads();
    }
    LAS float* Aa = AU + (2 * dir) * 64 * LR_P; LAS float* Ua = AU + (2 * dir + 1) * 64 * LR_P;
    int cidx = blockIdx.x >> 4;
    u32x4 xn[4]; u32x4 grn = (u32x4){0u, 0u, 0u, 0u};
    if (cidx < NCHUNK) { lru_load_x(Z, cidx, nb, C.tid, xn);
        if (PASS == 2) { grn = *(const u32x4*)(Z + (size_t)(cidx * 64 + ct_t) * DINP + ZC_GR + nb * 64 + c8); } }
#pragma unroll 1
    for (; cidx < NCHUNK; cidx += cstep) {
        u32x4 xv[4]; const u32x4 gr = grn;
#pragma unroll
        for (int k = 0; k < 4; ++k) xv[k] = xn[k];
        {
            float acc[8];
#pragma unroll
            for (int i = 0; i < 8; ++i) acc[i] = cb[i];
#pragma unroll
            for (int k = 0; k < 4; ++k) { const u32x4 x = xv[k];
                acc[0] += bf_lo(x.x) * cw[k][0]; acc[1] += bf_hi(x.x) * cw[k][1]; acc[2] += bf_lo(x.y) * cw[k][2]; acc[3] += bf_hi(x.y) * cw[k][3];
                acc[4] += bf_lo(x.z) * cw[k][4]; acc[5] += bf_hi(x.z) * cw[k][5]; acc[6] += bf_lo(x.w) * cw[k][6]; acc[7] += bf_hi(x.w) * cw[k][7]; }
            u32x4 w; w.x = cvt_pk_bf16(acc[0], acc[1]); w.y = cvt_pk_bf16(acc[2], acc[3]); w.z = cvt_pk_bf16(acc[4], acc[5]); w.w = cvt_pk_bf16(acc[6], acc[7]);
            *(LAS u32x4*)(XLB + ct_t * 72 + c8) = w;
            *(LAS f32x4*)(XLF + ct_t * LR_P + c8) = (f32x4){acc[0], acc[1], acc[2], acc[3]}; *(LAS f32x4*)(XLF + ct_t * LR_P + c8 + 4) = (f32x4){acc[4], acc[5], acc[6], acc[7]};
        }
        __syncthreads(); E.A();
        { const int cnext = cidx + cstep;
          if (cnext < NCHUNK) { lru_load_x(Z, cnext, nb, C.tid, xn);
              if (PASS == 2) { grn = *(const u32x4*)(Z + (size_t)(cnext * 64 + ct_t) * DINP + ZC_GR + nb * 64 + c8); } } }
#pragma unroll
        for (int s2 = 0; s2 < 2; ++s2) {
            const int q = C.wave * 2 + s2, tt = q >> 2, ct = q & 3;
            f32x4 g[4];
#pragma unroll
            for (int gi = 0; gi < 4; ++gi) g[gi] = (f32x4){0.f, 0.f, 0.f, 0.f};
#pragma unroll
            for (int ks = 0; ks < 2; ++ks) {
                const bf16x8 av = *(const LAS bf16x8*)(XLB + (tt * 16 + fr) * 72 + ks * 32 + fq * 8);
#pragma unroll
                for (int gi = 0; gi < 4; ++gi) { const bf16x8 bv = *(const LAS bf16x8*)(C.lds + LR_LW + ((gi * 64 + ct * 16 + fr) * 72 + ks * 32 + fq * 8) * 2);
                    g[gi] = __builtin_amdgcn_mfma_f32_16x16x32_bf16(av, bv, g[gi], 0, 0, 0); }
            }
            const int chl2 = ct * 16 + fr;
#pragma unroll
            for (int dd = 0; dd < 2; ++dd) {
#pragma unroll
                for (int j = 0; j < 4; ++j) { const int t = tt * 16 + 4 * fq + j;
                    const float p1 = 1.f + __builtin_amdgcn_exp2f(fminf(__builtin_fmaf(g[2 * dd][j], -LOG2E, gba[s2][dd]), 40.f)), p2 = 1.f + __builtin_amdgcn_exp2f(fminf(__builtin_fmaf(g[2 * dd + 1][j], -LOG2E, gbx[s2][dd]), 40.f));
                    const float inv = __builtin_amdgcn_rcpf(p1 * p2), r = p2 * inv, ig = p1 * inv;
                    const float av = __builtin_amdgcn_exp2f(gcc[s2][dd] * r), uv = __builtin_amdgcn_sqrtf(fmaxf(__builtin_fmaf(-av, av, 1.f), 0.f)) * ig * XLF[t * LR_P + chl2];
                    AU[(2 * dd) * 64 * LR_P + t * LR_P + chl2] = av; AU[(2 * dd + 1) * 64 * LR_P + t * LR_P + chl2] = uv; }
            }
        }
        __syncthreads(); E.B();
        {
            float Ap = 1.f, Hh = 0.f;
#pragma unroll
            for (int s2 = 0; s2 < 16; ++s2) { const int t = seg * 16 + (dir ? 15 - s2 : s2); const float av = Aa[t * LR_P + chl]; Hh = av * Hh + Ua[t * LR_P + chl]; Ap *= av; }
            SEG[(dir * 4 + seg) * 64 + chl] = (f32x2){Ap, Hh};
        }
        __syncthreads(); if (PASS == 2) E.A();
        if (PASS == 1) {
            if (seg == 0) { float At = 1.f, Ht = 0.f;
#pragma unroll
                for (int s2 = 0; s2 < 4; ++s2) { const f32x2 v = SEG[(dir * 4 + (dir ? 3 - s2 : s2)) * 64 + chl]; Ht = v[0] * Ht + v[1]; At *= v[0]; }
                ((f32x2*)(ws + WS_SUM))[((size_t)cidx * 2 + dir) * 1024 + nb * 64 + chl] = (f32x2){At, Ht}; }
        } else {
            float S = CARL[(((cidx - (int)(blockIdx.x >> 4)) / cstep) * 2 + dir) * 64 + chl];
            const int npre = dir ? 3 - seg : seg;
            for (int s2 = 0; s2 < npre; ++s2) { const f32x2 v = SEG[(dir * 4 + (dir ? 3 - s2 : s2)) * 64 + chl]; S = v[0] * S + v[1]; }
            { float av[16], uv[16];
#pragma unroll
              for (int s2 = 0; s2 < 16; ++s2) { const int t = seg * 16 + (dir ? 15 - s2 : s2); av[s2] = Aa[t * LR_P + chl]; uv[s2] = Ua[t * LR_P + chl]; }
#pragma unroll
              for (int s2 = 0; s2 < 16; ++s2) { const int t = seg * 16 + (dir ? 15 - s2 : s2); S = av[s2] * S + uv[s2]; Ua[t * LR_P + chl] = S; } }
            __syncthreads(); E.B();
            const int row = cidx * 64 + ct_t;
            const float gv[8] = {bf_lo(gr.x), bf_hi(gr.x), bf_lo(gr.y), bf_hi(gr.y), bf_lo(gr.z), bf_hi(gr.z), bf_lo(gr.w), bf_hi(gr.w)};
            float o[8];
#pragma unroll
            for (int i = 0; i < 8; ++i) o[i] = (AU[1 * 64 * LR_P + ct_t * LR_P + c8 + i] + AU[3 * 64 * LR_P + ct_t * LR_P + c8 + i]) * gelu_tanh(gv[i]);
            u32x4 w; w.x = cvt_pk_bf16(o[0], o[1]); w.y = cvt_pk_bf16(o[2], o[3]); w.z = cvt_pk_bf16(o[4], o[5]); w.w = cvt_pk_bf16(o[6], o[7]);
#if MRG_F8
            { u32x2 w8; w8.x = pack_fp8x4_sat(o[0] * F8_SL, o[1] * F8_SL, o[2] * F8_SL, o[3] * F8_SL); w8.y = pack_fp8x4_sat(o[4] * F8_SL, o[5] * F8_SL, o[6] * F8_SL, o[7] * F8_SL);
              *(u32x2*)(ws + WS_AL + (size_t)row * 2048 + 1024 + nb * 64 + c8) = w8; }
#else
            *(u32x4*)((bf16_t*)(ws + WS_AL) + (size_t)row * 2048 + 1024 + nb * 64 + c8) = w;
#endif
        }
    }
    __syncthreads();
    while (E.vR) { E.A(); __syncthreads(); E.B(); __syncthreads(); }
}
constexpr int P7_WRT = 0, P7_H2T = 66048, P7_RED = 99072, P7_GS = 115456, P7_LC = 140032, P7_BASE = 140160, P7_ENT = 140288, P7_PITCH = 1032;
__device__ __forceinline__ void phase_router(const Ctx& C0, const Args& a, int l, int Tm) {
    const Ctx C = fresh(C0); unsigned char* ws = C.ws; InArr in = C.in; (void)ws; (void)in;
    LAS bf16_t* H2T = (LAS bf16_t*)(C.lds + P7_WRT);
    LAS float* RED = (LAS float*)(C.lds + P7_H2T);
    LAS float* GS = (LAS float*)(C.lds + P7_GS); LAS float* SH = GS + 3072;
    LAS int* LCt = (LAS int*)(C.lds + P7_LC); LAS int* BASE = (LAS int*)(C.lds + P7_BASE); LAS int* ENT = (LAS int*)(C.lds + P7_ENT);
    const bf16_t* Wr = (const bf16_t*)(ws + WS_WL + (size_t)l * WL_STRIDE + OFF_WR);
    const int fr = C.lane & 15, fq = C.lane >> 4;
    bf16x8 bw0[4], bw1[4];
#pragma unroll
    for (int s = 0; s < 4; ++s) { const int k0 = C.wave * 128 + s * 32 + fq * 8; bw0[s] = *(const bf16x8*)(Wr + fr * 1024 + k0); bw1[s] = *(const bf16x8*)(Wr + (16 + fr) * 1024 + k0); }
    build_mod_tables(C, a, l, 1, GS, SH);
    if (C.tid < 32) LCt[C.tid] = 0;
    __syncthreads();
    const bf16_t* X = (const bf16_t*)(ws + WS_X); bf16_t* H = (bf16_t*)(ws + WS_H);
    const int ntile = Tm / 32;
    const float br = inp(in, I_BR)[l * NE + (C.tid & 31)];
    int it = 0;
    for (int tile = blockIdx.x; tile < ntile; tile += C.G, ++it) {
        u32x2 xw[4][4];
#pragma unroll
        for (int rr = 0; rr < 4; ++rr)
#pragma unroll
            for (int j = 0; j < 4; ++j) xw[rr][j] = *(const u32x2*)(X + (size_t)(tile * 32 + C.wave * 4 + rr) * D + 4 * C.lane + 256 * j);
#pragma unroll
        for (int rr = 0; rr < 4; ++rr) {
            const int rl = C.wave * 4 + rr, row = tile * 32 + rl, r = row < TLAT ? (row >> 13) : 2;
            f32x4 v[4]; float s = 0.f;
#pragma unroll
            for (int j = 0; j < 4; ++j) { v[j] = bf4_to_f32x4(xw[rr][j]); s += (v[j][0] * v[j][0] + v[j][1] * v[j][1]) + (v[j][2] * v[j][2] + v[j][3] * v[j][3]); }
            const float rstd = __builtin_amdgcn_rsqf(wave_sum(s) * (1.f / 1024.f) + EPS);
#pragma unroll
            for (int j = 0; j < 4; ++j) { const int c = 4 * C.lane + 256 * j; const f32x4 g = *(const LAS f32x4*)(GS + r * 1024 + c), h = *(const LAS f32x4*)(SH + r * 1024 + c);
                const f32x4 y = v[j] * rstd * g + h; u32x2 w; w.x = cvt_pk_bf16(y[0], y[1]); w.y = cvt_pk_bf16(y[2], y[3]);
                *(unsigned*)((unsigned char*)H + (size_t)row * D + c) = pack_fp8x4_sat(y[0], y[1], y[2], y[3]); *(LAS u32x2*)(H2T + rl * P7_PITCH + c) = w; }
        }
        __syncthreads();
#pragma unroll
        for (int t2 = 0; t2 < 2; ++t2) {
            f32x4 acc0 = (f32x4){0.f, 0.f, 0.f, 0.f}, acc1 = acc0;
#pragma unroll
            for (int s = 0; s < 4; ++s) { const int k0 = C.wave * 128 + s * 32 + fq * 8;
                const bf16x8 av = *(const LAS bf16x8*)(H2T + (t2 * 16 + fr) * P7_PITCH + k0);
                acc0 = __builtin_amdgcn_mfma_f32_16x16x32_bf16(av, bw0[s], acc0, 0, 0, 0); acc1 = __builtin_amdgcn_mfma_f32_16x16x32_bf16(av, bw1[s], acc1, 0, 0, 0); }
#pragma unroll
            for (int j = 0; j < 4; ++j) { RED[((t2 * 8 + C.wave) * 16 + 4 * fq + j) * 32 + fr] = acc0[j]; RED[((t2 * 8 + C.wave) * 16 + 4 * fq + j) * 32 + 16 + fr] = acc1[j]; }
        }
        __syncthreads();
#pragma unroll
        for (int t2 = 0; t2 < 2; ++t2) {
            const int rl = C.tid >> 5, e = C.tid & 31;
            float v = br;
#pragma unroll
            for (int w = 0; w < 8; ++w) v += RED[((t2 * 8 + w) * 16 + rl) * 32 + e];
            float tv[4]; int ti[4];
#pragma unroll
            for (int k = 0; k < 4; ++k) { float mv = v; int mi = e;
#pragma unroll
                for (int off = 1; off < 32; off <<= 1) { const float ov = __shfl_xor(mv, off); const int oi = __shfl_xor(mi, off); if (ov > mv || (ov == mv && oi < mi)) { mv = ov; mi = oi; } }
                tv[k] = mv; ti[k] = mi; if (e == mi) v = -INFINITY; }
            const float e1 = fast_exp(tv[1] - tv[0]), e2 = fast_exp(tv[2] - tv[0]), e3 = fast_exp(tv[3] - tv[0]), inv = 1.f / (1.f + e1 + e2 + e3);
            if (e < 4) { const int me = e == 0 ? ti[0] : e == 1 ? ti[1] : e == 2 ? ti[2] : ti[3]; const float mw = (e == 0 ? 1.f : e == 1 ? e1 : e == 2 ? e2 : e3) * inv;
                const int rank = atomicAdd((int*)(LCt + me), 1);
                const int idx = (it * 32 + t2 * 16 + rl) * 4 + e; ENT[idx * 3] = me; ENT[idx * 3 + 1] = rank; ENT[idx * 3 + 2] = __float_as_int(mw); }
        }
        __syncthreads();
    }
    if (C.tid < 32) { const int n = LCt[C.tid]; BASE[C.tid] = n ? (int)atomicAdd((unsigned*)(ws + WS_CTL) + CW_CNT + (l * 32 + C.tid) * 64, (unsigned)n) : 0; }
    __syncthreads();
    unsigned* TOKE = (unsigned*)(ws + WS_TOKE);
    for (int i = C.tid; i < it * 128; i += 512) { const int iti = i >> 7, rl = (i >> 2) & 31, k = i & 3, row = (blockIdx.x + iti * C.G) * 32 + rl;
        const int me = ENT[i * 3], pos = BASE[me] + ENT[i * 3 + 1]; TOKE[row * 4 + k] = (unsigned)me | ((unsigned)pos << 5);
        ((u32x2*)(ws + WS_LIST))[(size_t)me * LCAP + pos] = (u32x2){(unsigned)row, (unsigned)ENT[i * 3 + 2]}; }
}
__device__ __forceinline__ void build_tp(const Ctx& C0, int l, LAS int* tp) {
    const Ctx C = fresh(C0); unsigned char* ws = C.ws; InArr in = C.in; (void)ws; (void)in;
    if (C.tid < 64) {
        const unsigned* cnt = (const unsigned*)(ws + WS_CTL) + CW_CNT + l * 32 * 64; const int e = C.tid & 31;
        const unsigned n = cnt[e * 64]; int sc = (int)((n + 255u) >> 8);
#pragma unroll
        for (int off = 1; off < 32; off <<= 1) { const int o = __shfl_up(sc, off, 32); if (e >= off) sc += o; }
        if (C.tid < 32) { tp[e + 1] = sc; tp[33 + e] = (int)n; if (e == 0) tp[0] = 0; } }
    __syncthreads();
}
__device__ __forceinline__ void phase_combine(const Ctx& C0, const Args& a, int l, int Tm) {
    const Ctx C = fresh(C0); unsigned char* ws = C.ws; InArr in = C.in; (void)ws; (void)in;
    LAS int* tp = (LAS int*)(C.lds); LAS float* G2 = (LAS float*)(C.lds + 1024); LAS float* GS = G2 + 3072; LAS float* SH = GS + 3072;
    build_tp(C, l, tp);
    const float* MOD = (const float*)(ws + WS_MOD);
    for (int i = C.tid; i < 3072; i += 512) G2[i] = MOD[(size_t)(l * 3 + (i >> 10)) * 6144 + 5120 + (i & 1023)];
    if (l == 0) build_mod_tables(C, a, 1, 0, GS, SH);
    else for (int i = C.tid; i < 1024; i += 512) GS[i] = inp(in, I_FN)[i];
    __syncthreads();
    bf16_t* X = (bf16_t*)(ws + WS_X); bf16_t* H = (bf16_t*)(ws + WS_H); const bf16_t* Y = (const bf16_t*)(ws + WS_XS);
    const unsigned* TOKE = (const unsigned*)(ws + WS_TOKE);
    static_assert(Y_F8 == 1, "combine reads Y as e4m3 x8");
    for (int row0 = blockIdx.x * 8 + C.wave; row0 < Tm; row0 += C.G * 16) {
        const int nrow = (row0 + C.G * 8 < Tm) ? 2 : 1;
        unsigned te[2][4];
#pragma unroll
        for (int q = 0; q < 2; ++q) { const int row = (q < nrow) ? row0 + q * C.G * 8 : row0;
#pragma unroll
            for (int k = 0; k < 4; ++k) te[q][k] = TOKE[row * 4 + k]; }
        unsigned yw[2][4][4]; u32x2 xw[2][4];
#pragma unroll
        for (int q = 0; q < 2; ++q) { const int row = (q < nrow) ? row0 + q * C.G * 8 : row0;
#pragma unroll
            for (int j = 0; j < 4; ++j) { const int c = 4 * C.lane + 256 * j;
#pragma unroll
                for (int k = 0; k < 4; ++k) { const int slot = tp[te[q][k] & 31] * 256 + (int)(te[q][k] >> 5); yw[q][j][k] = *(const unsigned*)((const unsigned char*)Y + (size_t)slot * D + c); }
                xw[q][j] = *(const u32x2*)(X + (size_t)row * D + c); } }
#pragma unroll
        for (int q = 0; q < 2; ++q) { if (q < nrow) { const int row = row0 + q * C.G * 8, r = row < TLAT ? (row >> 13) : 2;
            f32x4 v[4];
#pragma unroll
            for (int j = 0; j < 4; ++j) { const int c = 4 * C.lane + 256 * j; f32x4 y = (f32x4){0.f, 0.f, 0.f, 0.f};
#pragma unroll
                for (int k = 0; k < 4; ++k) { const unsigned w = yw[q][j][k];
                    const f32x2 lo = __builtin_amdgcn_cvt_pk_f32_fp8((int)w, false), hi2 = __builtin_amdgcn_cvt_pk_f32_fp8((int)w, true); y += (f32x4){lo[0], lo[1], hi2[0], hi2[1]} * 0.125f; }
                v[j] = bf4_to_f32x4(xw[q][j]) + *(const LAS f32x4*)(G2 + r * 1024 + c) * y; }
            if (l == 0) {
#pragma unroll
                for (int j = 0; j < 4; ++j) { u32x2 w; w.x = cvt_pk_bf16(v[j][0], v[j][1]); w.y = cvt_pk_bf16(v[j][2], v[j][3]); *(u32x2*)(X + (size_t)row * D + 4 * C.lane + 256 * j) = w; }
                norm_store_bf16(v, GS + r * 1024, SH + r * 1024, H + (size_t)row * (G1_F8 ? D / 2 : D), C.lane);
            } else {
                float s2 = 0.f;
#pragma unroll
                for (int j = 0; j < 4; ++j) s2 += (v[j][0] * v[j][0] + v[j][1] * v[j][1]) + (v[j][2] * v[j][2] + v[j][3] * v[j][3]);
                const float rstd = __builtin_amdgcn_rsqf(wave_sum(s2) * (1.f / 1024.f) + EPS);
#pragma unroll
                for (int j = 0; j < 4; ++j) { const int c = 4 * C.lane + 256 * j; *(f32x4*)(a.out + (size_t)row * D + c) = v[j] * rstd * *(const LAS f32x4*)(GS + c); }
            } } }
    }
}

__device__ __forceinline__ void ph_g1(const Ctx& C, LAS unsigned char* ldsl, int l) {
    unsigned char* ws = opq(C.ws); unsigned char* wl = ws + WS_WL + (size_t)l * WL_STRIDE;
    pg8::TileOrderT<G1_F8 != 0> S; S.init(ws + WS_H, G1_F8 ? D / 2 : D, wl + OFF_WIN, G1_F8 ? D / 2 : D, T / 256, DINP / 256, C.G, opq_i(blockIdx.x));
    EpiZ E{(bf16_t*)(ws + WS_Z), (float*)(ws + WS_SSQ)};
    pg8::gemm_phase<EpiZ, pg8::TileOrderT<G1_F8 != 0>, G1_F8 != 0>(ldsl, opq_i(G1_F8 ? D / 2 : D), S, E);
}
__device__ __forceinline__ void ph_g2(const Ctx& C, LAS unsigned char* ldsl, int l) {
    unsigned char* ws = opq(C.ws); unsigned char* wl = ws + WS_WL + (size_t)l * WL_STRIDE;
    pg8::TileOrder S; S.init(ws + WS_Z + ZC_CQ * 2, DINP, wl + OFF_WUQ, 256, (l == 0) ? T / 256 : TLAT / 256, NQ / 256, C.G, blockIdx.x);
    EpiQ E{(bf16_t*)(ws + WS_Q), (const float*)(ws + WS_SSQ), (const float*)(ws + WS_TAB)};
    pg8::gemm_phase<EpiQ, pg8::TileOrder>(ldsl, opq_i(256), S, E);
}
__device__ __forceinline__ void ph_g3(const Ctx& C, LAS unsigned char* ldsl, int l) {
    unsigned char* ws = opq(C.ws); unsigned char* wl = ws + WS_WL + (size_t)l * WL_STRIDE;
    pg8::TileOrder S; S.init(ws + WS_Z + ZC_CKV * 2, DINP, wl + OFF_WUKV, 128, T / 256, NKV / 256, C.G, (blockIdx.x + 128) % C.G);
    EpiKV E{(bf16_t*)(ws + WS_KV), (const float*)(ws + WS_SSQ) + (size_t)T * 4, ws + WS_K8};
    pg8::gemm_phase<EpiKV, pg8::TileOrder>(ldsl, opq_i(128), S, E);
}
__device__ __forceinline__ void ph_attn(const Ctx& C0, int l) {
    const Ctx C = fresh(C0); unsigned char* ws = C.ws;
    const unsigned char* Q = ws + WS_Q; const bf16_t* KV = (const bf16_t*)(ws + WS_KV); const unsigned char* KPE = ws + WS_KPE; bf16_t* AL = (bf16_t*)(ws + WS_AL);
    NoTick E;
    const int nunit = (l == 0) ? 528 : 512;
    const int vcu = (C.G % 8 == 0) ? (int)(blockIdx.x % 8) * (C.G / 8) + (int)(blockIdx.x / 8) : (int)blockIdx.x;
    for (int uidx = vcu; uidx < nunit; uidx += C.G) {
        int b, h, qrow, NT;
        if (uidx < 512) { const int bh = uidx >> 5, qb = uidx & 31; b = bh >> 3; h = bh & 7; qrow = b * SEQ + qb * 256; NT = 132; }
        else { const int u2 = uidx - 512; b = u2 >> 3; h = u2 & 7; qrow = TLAT + b * CTXL; NT = 4; }
        att::attn_unit(Q + (size_t)qrow * NQ + h * 192, ws + WS_K8 + h * 128, ws + WS_KV + (size_t)(b * 8 + h) * 128 * KTOT, KPE, TLAT + b * CTXL, b * SEQ, NT, NT == 132 ? (vcu & 31) * 4 : 0,
                       MRG_F8 ? (bf16_t*)((unsigned char*)AL + (size_t)qrow * 2048 + h * 128) : AL + (size_t)qrow * 2048 + h * 128, (char*)C.lds, E);
    }
}
__device__ __forceinline__ void ph_merge(const Ctx& C, LAS unsigned char* ldsl, int l) {
    unsigned char* ws = opq(C.ws); InArr in = opq_in(C.in); unsigned char* wl = ws + WS_WL + (size_t)l * WL_STRIDE;
    constexpr int EU = MRG_F8 ? 2 : 1;
    pg8::TileOrderT<MRG_F8 != 0> S; S.init(ws + WS_AL, 2048 / EU, wl + OFF_WM, 2048 / EU, (l == 0) ? T / 256 : TLAT / 256, D / 256, C.G, blockIdx.x, 1, 1024 / EU);
    EpiM E{(const bf16_t*)(ws + WS_Z), inp(in, I_BBG) + l * 2048, (bf16_t*)(ws + WS_M)};
    pg8::gemm_phase<EpiM, pg8::TileOrderT<MRG_F8 != 0>, MRG_F8 != 0>(ldsl, opq_i(D / EU), S, E);
}
__device__ __forceinline__ void ph_wout(const Ctx& C, LAS unsigned char* ldsl, int l) {
    unsigned char* ws = opq(C.ws); InArr in = opq_in(C.in); unsigned char* wl = ws + WS_WL + (size_t)l * WL_STRIDE;
    constexpr int EU = MRG_F8 ? 2 : 1;
    pg8::TileOrderT<MRG_F8 != 0> S; S.init(ws + WS_M, D / EU, wl + OFF_WOUT, D / EU, (l == 0) ? T / 256 : TLAT / 256, D / 256, C.G, blockIdx.x);
    EpiX E{inp(in, I_X), inp(in, I_CTX), (const float*)(ws + WS_MOD) + (size_t)l * 3 * 6144 + 2048, (bf16_t*)(ws + WS_X), l != 0};
    pg8::gemm_phase<EpiX, pg8::TileOrderT<MRG_F8 != 0>, MRG_F8 != 0>(ldsl, opq_i(D / EU), S, E);
}
__device__ __forceinline__ void ph_moe1(const Ctx& C, LAS unsigned char* ldsl, int l) {
    unsigned char* ws = opq(C.ws); InArr in = opq_in(C.in);
    LAS int* tp = (LAS int*)(ldsl + 140000); build_tp(C, l, tp);
    pg8::MoeOrder<true> S; S.A = (const char*)(ws + WS_H); S.B = (const char*)(ws + WS_WGU + (size_t)l * WGU_STRIDE); S.lda = D / 2; S.ldb = D / 2; S.tp = tp; S.NT = 8; S.G = C.G; S.c = (C.G % 8 == 0) ? (int)(blockIdx.x % 8) * (C.G / 8) + (int)(blockIdx.x / 8) : (int)blockIdx.x; S.total = tp[32] * 8; S.list = (const u32x2*)(ws + WS_LIST);
    S.build_lists((LAS int*)(ldsl + 141056), C.tid);
    EpiACT E{(unsigned char*)(ws + WS_ACT), inp(in, I_BEG) + l * NE * D, inp(in, I_BEU) + l * NE * D};
    pg8::gemm_phase<EpiACT, pg8::MoeOrder<true>, true>(ldsl, opq_i(D / 2), S, E);
}
__device__ __forceinline__ void ph_moe2(const Ctx& C, LAS unsigned char* ldsl, int l) {
    unsigned char* ws = opq(C.ws); InArr in = opq_in(C.in);
    LAS int* tp = (LAS int*)(ldsl + 140000); build_tp(C, l, tp);
    pg8::MoeOrder<true> S; S.A = (const char*)(ws + WS_ACT); S.B = (const char*)(ws + WS_WD + (size_t)l * WD_STRIDE); S.lda = MOE2_F8 ? D / 2 : D; S.ldb = MOE2_F8 ? D / 2 : D; S.tp = tp; S.NT = 4; S.G = C.G; S.c = (C.G % 8 == 0) ? (int)(blockIdx.x % 8) * (C.G / 8) + (int)(blockIdx.x / 8) : (int)blockIdx.x; S.total = tp[32] * 4; S.list = nullptr;
    S.build_lists((LAS int*)(ldsl + 141056), C.tid);
    EpiY E{(bf16_t*)(ws + WS_XS), inp(in, I_BED) + l * NE * D, (const u32x2*)(ws + WS_LIST)};
    pg8::gemm_phase<EpiY, pg8::MoeOrder<true>, MOE2_F8 != 0>(ldsl, opq_i(MOE2_F8 ? D / 2 : D), S, E);
}

constexpr int NPHASE = 20;
__global__ void __launch_bounds__(512, 2) fwd(Args a) {
    extern __shared__ __attribute__((aligned(16))) unsigned char lds_raw[];
    Ctx C; C.lds = lds_raw; C.ws = a.ws; C.tid = threadIdx.x; C.lane = C.tid & 63; C.wave = __builtin_amdgcn_readfirstlane(C.tid >> 6); C.G = gridDim.x; C.in = (InArr)__builtin_amdgcn_kernarg_segment_ptr();
    LAS unsigned char* ldsl = (LAS unsigned char*)lds_raw;
    volatile LAS unsigned* MISC = (volatile LAS unsigned*)(ldsl + MISC_OFF);
    if (C.tid < 64) MISC[C.tid] = 0u;
    __syncthreads();
    const bool use_bar = (a.ph_hi - a.ph_lo) > 1;
    XcdBarrier bar; bar.bar = (unsigned*)(C.ws + WS_CTL) + CW_BAR; bar.x = 0; bar.st = MISC + 8;
    if (use_bar) bar = xcd_barrier_post((unsigned*)(C.ws + WS_CTL) + CW_BAR, MISC + 8);
    const int lo = a.ph_lo, hi = a.ph_hi;
#ifndef PH_MASK
#define PH_MASK 0xffffffffu
#endif
#define PHBIT(k) ((k) < 2 ? (k) : 2 + ((k) - 2) % 9)
#define IN(k) (((PH_MASK >> PHBIT(k)) & 1u) && lo <= (k) && (k) < hi)
#define SEAM(k) do { if (lo <= (k) && (k) + 1 < hi) xcd_barrier(bar); } while (0)

#ifndef REP_MASK
#define REP_MASK 0u
#endif
#define RUN(bit, stmt) do { stmt; if ((REP_MASK >> (bit)) & 1u) { __syncthreads(); stmt; } } while (0)
    if (IN(0)) { phase_adaln(C, a); } SEAM(0);
    if (IN(1)) { RUN(0, phase_prologue(C, a)); } SEAM(1);
#pragma unroll 1
    for (int l = 0; l < 2; ++l) {
        const int pb = 2 + 9 * l;
        const int Tm = (l == 0) ? T : TLAT;
        if (IN(pb + 0)) { RUN(1, ph_g1(C, ldsl, l)); } SEAM(pb + 0);
        if (IN(pb + 1)) { RUN(2, ph_g2(C, ldsl, l)); RUN(3, ph_g3(C, ldsl, l)); RUN(4, lru_pass<1>(C, a, l)); RUN(5, kpe_rope(C)); } SEAM(pb + 1);
        if (IN(pb + 2)) { RUN(7, ph_attn(C, l)); RUN(8, lru_pass<2>(C, a, l)); } SEAM(pb + 2);
        if (IN(pb + 3)) { RUN(9, ph_merge(C, ldsl, l)); } SEAM(pb + 3);
        if (IN(pb + 4)) { ph_wout(C, ldsl, l); } SEAM(pb + 4);
        if (IN(pb + 5)) { phase_router(C, a, l, Tm); } SEAM(pb + 5);
        if (IN(pb + 6)) { RUN(13, ph_moe1(C, ldsl, l)); } SEAM(pb + 6);
        if (IN(pb + 7)) { RUN(14, ph_moe2(C, ldsl, l)); } SEAM(pb + 7);
        if (IN(pb + 8)) { phase_combine(C, a, l, Tm); } SEAM(pb + 8);
    }
#undef IN
#undef SEAM
}

extern "C" void kernel_launch(void* const* d_in, const int* in_sizes, int n_in, void* d_out, int out_size, void* d_ws, size_t ws_size, hipStream_t stream) {
    static int grid = 0;
    if (grid == 0) {
        if (n_in != 33 || in_sizes[0] != TLAT * D || out_size != TLAT * D || ws_size < WS_END) {
            fprintf(stderr, "kernel_launch: shape/workspace mismatch: n_in %d in0 %d out %d ws %zu (need >= %zu)\n", n_in, n_in > 0 ? in_sizes[0] : -1, out_size, ws_size, (size_t)WS_END); grid = -1; return; }
        int dev = 0, cus = 0, per_cu = 0;
        if (hipGetDevice(&dev) != hipSuccess || hipDeviceGetAttribute(&cus, hipDeviceAttributeMultiprocessorCount, dev) != hipSuccess) { grid = -1; return; }
        if (hipFuncSetAttribute((const void*)fwd, hipFuncAttributeMaxDynamicSharedMemorySize, LDS_BYTES) != hipSuccess) { fprintf(stderr, "kernel_launch: hipFuncSetAttribute failed\n"); grid = -1; return; }
        if (hipOccupancyMaxActiveBlocksPerMultiprocessor(&per_cu, (const void*)fwd, 512, LDS_BYTES) != hipSuccess || per_cu < 1) fprintf(stderr, "kernel_launch: occupancy query reports %d\n", per_cu);
        (void)hipGetLastError();
        grid = cus;
    }
    if (grid < 0) return;
    (void)hipMemsetAsync((char*)d_ws + WS_CTL, 0, CTL_BYTES, stream);
    Args a{};
    for (int i = 0; i < 33; ++i) a.in[i] = (const float*)d_in[i];
    a.out = (float*)d_out; a.ws = (unsigned char*)d_ws;
#if MULTI_LAUNCH
    for (int p = 0; p < NPHASE; ++p) { a.ph_lo = p; a.ph_hi = p + 1; hipLaunchKernelGGL(fwd, dim3(grid), dim3(512), LDS_BYTES, stream, a); }
#else
    a.ph_lo = 0; a.ph_hi = NPHASE; hipLaunchKernelGGL(fwd, dim3(grid), dim3(512), LDS_BYTES, stream, a);
#endif
    const hipError_t le = hipPeekAtLastError();
    if (le != hipSuccess) fprintf(stderr, "kernel_launch: launch failed: %s\n", hipGetErrorName(le));
}
```
